# Optimizing an MI355X kernel written in HIP

```python
import math
import jax, jax.numpy as jnp
from jax import lax
import numpy as np

D_MODEL = 1024
BATCH = 32
SEQ = 2048
DEPTH = 2
DEC_BATCH = 16
DEC_SEQ = 2048
PAST_LEN = 128

GLA_HEADS = 4
GLA_DK = 64
GLA_DV = 128
GLA_QK_W = GLA_HEADS * GLA_DK
GLA_V_W = GLA_HEADS * GLA_DV
GATE_RANK = 16
GATE_TAU = 16.0
CHUNK = 64
NAT_HEADS = 8
NAT_HD = 64
NAT_W = NAT_HEADS * NAT_HD
GRID_W = 64
MAX_KR = 8
KC = 16
QB = 16
KB = 32
PROJ_SIZES = (GLA_QK_W, GLA_QK_W, GLA_V_W, GLA_V_W, 2 * GATE_RANK, NAT_W, NAT_W, NAT_W)
PROJ_W = 3104
MIX_W = GLA_V_W + NAT_W
FFN_HIDDEN = ((8 * D_MODEL + 3 * 256 - 1) // (3 * 256)) * 256
ALPHA = (2 * DEPTH) ** 0.25
BETA = (8 * DEPTH) ** -0.25
LN_EPS = 1e-5

kernel_name = "hybrid_gla_natten_deepnorm_encoder"


def _layer_norm(x, g, b):
    xf = x.astype(jnp.float32)
    mu = jnp.mean(xf, axis=-1, keepdims=True)
    var = jnp.mean(jnp.square(xf - mu), axis=-1, keepdims=True)
    y = (xf - mu) * lax.rsqrt(var + LN_EPS) * g.astype(jnp.float32) + b.astype(jnp.float32)
    return y.astype(x.dtype)


def _gla_chunked(q, k, v, g, include_diag):
    B, H, L, dk = q.shape
    dv = v.shape[-1]
    n = L // CHUNK
    f32 = jnp.float32
    q = q.astype(f32).reshape(B, H, n, CHUNK, dk)
    k = k.astype(f32).reshape(B, H, n, CHUNK, dk)
    v = v.astype(f32).reshape(B, H, n, CHUNK, dv)
    g = g.astype(f32).reshape(B, H, n, CHUNK, dk)
    bcum = jnp.cumsum(g, axis=3)
    b_last = bcum[:, :, :, -1:, :]
    q_dec = q * jnp.exp(bcum)
    k_inv = k * jnp.exp(-bcum)
    k_end = k * jnp.exp(b_last - bcum)
    mask = jnp.tril(jnp.ones((CHUNK, CHUNK), dtype=bool), k=0 if include_diag else -1)
    scores = jnp.einsum('bhncd,bhnsd->bhncs', q_dec, k_inv)
    intra = jnp.einsum('bhncs,bhnsv->bhncv', jnp.where(mask, scores, 0.0), v)
    dS = jnp.einsum('bhnsd,bhnsv->bhndv', k_end, v)
    decay = jnp.exp(b_last[:, :, :, 0, :])

    def step(S, inp):
        dec, ds = inp
        return dec[..., None] * S + ds, S

    S0 = jnp.zeros((B, H, dk, dv), f32)
    _, S_before = lax.scan(step, S0, (jnp.moveaxis(decay, 2, 0), jnp.moveaxis(dS, 2, 0)))
    S_before = jnp.moveaxis(S_before, 0, 2)
    inter = jnp.einsum('bhncd,bhndv->bhncv', q_dec, S_before)
    return (intra + inter).reshape(B, H, L, dv)


def _nat_col_tables():
    nqb = GRID_W // QB
    qcols = np.arange(GRID_W).reshape(nqb, QB)
    col_start = np.clip(qcols - KC // 2, 0, GRID_W - KC)
    blk_start = np.clip(np.arange(nqb) * QB - KC // 2, 0, GRID_W - KB)
    key_cols = blk_start[:, None] + np.arange(KB)
    kc3 = key_cols[:, None, :]
    valid = (kc3 >= col_start[:, :, None]) & (kc3 < col_start[:, :, None] + KC)
    co_idx = np.clip(kc3 - qcols[:, :, None] + KC - 1, 0, 2 * KC - 2)
    return (jnp.asarray(key_cols, jnp.int32), jnp.asarray(valid), jnp.asarray(co_idx, jnp.int32))


def _neighborhood_attention(q, k, v, rpb):
    B, L, H, d = q.shape
    rows = L // GRID_W
    kr = min(MAX_KR, rows)
    nqb = GRID_W // QB
    key_cols, valid, co_idx = _nat_col_tables()
    qg = (q * (d ** -0.5)).reshape(B, rows, GRID_W, H, d)
    kg = k.reshape(B, rows, GRID_W, H, d)
    vg = v.reshape(B, rows, GRID_W, H, d)

    def row_fn(r):
        rs = jnp.clip(r - kr // 2, 0, rows - kr)
        k_rows = lax.dynamic_slice_in_dim(kg, rs, kr, axis=1)
        v_rows = lax.dynamic_slice_in_dim(vg, rs, kr, axis=1)
        k_blk = k_rows[:, :, key_cols]
        v_blk = v_rows[:, :, key_cols]
        q_row = lax.dynamic_index_in_dim(qg, r, axis=1, keepdims=False).reshape(B, nqb, QB, H, d)
        s = jnp.einsum('bjqhd,bkjmhd->bhjqkm', q_row, k_blk).astype(jnp.float32)
        ro = rs + jnp.arange(kr) - r + (MAX_KR - 1)
        bias = rpb[:, ro[:, None, None, None], co_idx[None]]
        s = s + jnp.transpose(bias, (0, 2, 3, 1, 4)).astype(jnp.float32)[None]
        s = jnp.where(valid[None, None, :, :, None, :], s, -1e30)
        p = jax.nn.softmax(s.reshape(B, H, nqb, QB, kr * KB), axis=-1).reshape(s.shape)
        o = jnp.einsum('bhjqkm,bkjmhd->bjqhd', p.astype(v.dtype), v_blk)
        return o.reshape(B, GRID_W, H, d)

    out = lax.map(row_fn, jnp.arange(rows))
    return jnp.transpose(out, (1, 0, 2, 3, 4)).reshape(B, L, H * d)


def _token_mixer(x, w_in, gate_w2, gate_b, gla_norm_g, rpb, w_out):
    B, L, _ = x.shape
    f32 = jnp.float32
    proj = x @ w_in
    points = [int(p) for p in np.cumsum(PROJ_SIZES)[:-1]]
    q_a, k_a, v_a, r_a, lr, q_b, k_b, v_b = jnp.split(proj, points, axis=-1)

    def heads(t, h, dh):
        return t.reshape(B, L, h, dh).transpose(0, 2, 1, 3)

    qa = heads(q_a, GLA_HEADS, GLA_DK) * (GLA_DK ** -0.5)
    ka = heads(k_a, GLA_HEADS, GLA_DK)
    va = heads(v_a, GLA_HEADS, GLA_DV)
    lr = lr.astype(f32)
    g_f = jax.nn.log_sigmoid(lr[..., :GATE_RANK] @ gate_w2[0].astype(f32) + gate_b[0].astype(f32)) / GATE_TAU
    g_b = jax.nn.log_sigmoid(lr[..., GATE_RANK:] @ gate_w2[1].astype(f32) + gate_b[1].astype(f32)) / GATE_TAU
    g_f = heads(g_f, GLA_HEADS, GLA_DK)
    g_b = heads(g_b, GLA_HEADS, GLA_DK)
    o_fwd = _gla_chunked(qa, ka, va, g_f, True)
    o_bwd = _gla_chunked(qa[:, :, ::-1], ka[:, :, ::-1], va[:, :, ::-1], g_b[:, :, ::-1], False)[:, :, ::-1]
    o = (o_fwd + o_bwd).transpose(0, 2, 1, 3)
    o = o * lax.rsqrt(jnp.mean(jnp.square(o), axis=-1, keepdims=True) + LN_EPS)
    o = o * gla_norm_g.astype(f32).reshape(GLA_HEADS, GLA_DV)
    o_a = (o.reshape(B, L, GLA_V_W) * jax.nn.silu(r_a.astype(f32))).astype(x.dtype)

    o_n = _neighborhood_attention(q_b.reshape(B, L, NAT_HEADS, NAT_HD),
                                  k_b.reshape(B, L, NAT_HEADS, NAT_HD),
                                  v_b.reshape(B, L, NAT_HEADS, NAT_HD), rpb)
    return jnp.concatenate([o_a, o_n.astype(x.dtype)], axis=-1) @ w_out


def _swiglu(x, w_ffn_in, w_ffn_out):
    h = x @ w_ffn_in
    gate, up = jnp.split(h, 2, axis=-1)
    return (jax.nn.silu(gate) * up) @ w_ffn_out


def _trunk(x, w_in, gla_gate_w2, gla_gate_b, gla_norm_g, nat_rpb, w_out,
           ln1_g, ln1_b, w_ffn_in, w_ffn_out, ln2_g, ln2_b):
    for l in range(DEPTH):
        mix = _token_mixer(x, w_in[l], gla_gate_w2[l], gla_gate_b[l], gla_norm_g[l], nat_rpb[l], w_out[l])
        x = _layer_norm(ALPHA * x + mix, ln1_g[l], ln1_b[l])
        x = _layer_norm(ALPHA * x + _swiglu(x, w_ffn_in[l], w_ffn_out[l]), ln2_g[l], ln2_b[l])
    return x


def setup_inputs(seed: int = 0) -> dict:
    key = jax.random.key(seed)
    ks = jax.random.split(key, 16)
    f32 = jnp.float32
    nrm = lambda k, s: jax.random.normal(k, s, f32)
    return {
        "x_prompt": nrm(ks[0], (BATCH, SEQ, D_MODEL)),
        "x_sample": nrm(ks[1], (DEC_BATCH, DEC_SEQ, D_MODEL)),
        "w_in": nrm(ks[2], (DEPTH, D_MODEL, PROJ_W)) * D_MODEL ** -0.5,
        "gla_gate_w2": nrm(ks[3], (DEPTH, 2, GATE_RANK, GLA_QK_W)) * GATE_RANK ** -0.5,
        "gla_gate_b": nrm(ks[4], (DEPTH, 2, GLA_QK_W)) * 0.1,
        "gla_norm_g": 1.0 + 0.01 * nrm(ks[5], (DEPTH, GLA_V_W)),
        "nat_rpb": 0.02 * nrm(ks[6], (DEPTH, NAT_HEADS, 2 * MAX_KR - 1, 2 * KC - 1)),
        "w_out": nrm(ks[7], (DEPTH, MIX_W, D_MODEL)) * (MIX_W ** -0.5) * BETA,
        "ln1_g": 1.0 + 0.01 * nrm(ks[8], (DEPTH, D_MODEL)),
        "ln1_b": 0.01 * nrm(ks[9], (DEPTH, D_MODEL)),
        "w_ffn_in": nrm(ks[10], (DEPTH, D_MODEL, 2 * FFN_HIDDEN)) * D_MODEL ** -0.5,
        "w_ffn_out": nrm(ks[11], (DEPTH, FFN_HIDDEN, D_MODEL)) * (FFN_HIDDEN ** -0.5) * BETA,
        "ln2_g": 1.0 + 0.01 * nrm(ks[12], (DEPTH, D_MODEL)),
        "ln2_b": 0.01 * nrm(ks[13], (DEPTH, D_MODEL)),
    }


def reference(x_prompt, x_sample, w_in, gla_gate_w2, gla_gate_b, gla_norm_g, nat_rpb, w_out,
              ln1_g, ln1_b, w_ffn_in, w_ffn_out, ln2_g, ln2_b):
    y_prompt = _trunk(x_prompt, w_in, gla_gate_w2, gla_gate_b, gla_norm_g, nat_rpb, w_out,
                      ln1_g, ln1_b, w_ffn_in, w_ffn_out, ln2_g, ln2_b)
    y_sample = _trunk(x_sample, w_in, gla_gate_w2, gla_gate_b, gla_norm_g, nat_rpb, w_out,
                      ln1_g, ln1_b, w_ffn_in, w_ffn_out, ln2_g, ln2_b)
    return (y_prompt, y_sample)
```

```cpp
#include <hip/hip_runtime.h>
#include <hip/hip_cooperative_groups.h>
#include <cstdio>
#ifndef NAT_REPS
#define NAT_REPS 1
#endif
#ifndef G1_REPS
#define G1_REPS 1
#endif
#ifndef G3_REPS
#define G3_REPS 1
#endif
#ifndef GEMM_REPS
#define GEMM_REPS 1
#endif
#ifndef MIX_REPS
#define MIX_REPS 1
#endif
#ifndef SYNC_REPS
#define SYNC_REPS 1
#endif
#ifndef NAIVE_NAT
#define NAIVE_NAT 0
#endif
#ifndef NAIVE_GLA
#define NAIVE_GLA 0
#endif
namespace cg = cooperative_groups;

#define LAS __attribute__((address_space(3)))
typedef unsigned short bf16_t;
typedef short bf16x8 __attribute__((ext_vector_type(8)));
typedef float f32x4 __attribute__((ext_vector_type(4)));
typedef unsigned u32x4 __attribute__((ext_vector_type(4)));
typedef unsigned u32x2 __attribute__((ext_vector_type(2)));

constexpr int DM = 1024, SEQ = 2048, CHB = 24, TC = CHB * SEQ, NCHUNK = 2, NPROMPT_ROWS = 32 * SEQ;
constexpr int NPROJ = 3328, NF1 = 5632, KF2 = 2816;
constexpr float ALPHA = 1.41421356237309515f, LN_EPS = 1e-5f;

constexpr size_t al256(size_t x) { return (x + 255) & ~(size_t)255; }
constexpr size_t OFF_WIN = 0;
constexpr size_t OFF_WOUT = OFF_WIN + al256(2ull * NPROJ * DM * 2);
constexpr size_t OFF_WF1 = OFF_WOUT + al256(2ull * DM * DM * 2);
constexpr size_t OFF_WF2 = OFF_WF1 + al256(2ull * NF1 * DM * 2);
constexpr size_t OFF_CV = OFF_WF2 + al256(2ull * DM * KF2 * 2);
constexpr size_t CV_BYTES = (2ull * NPROJ * 2 + 2ull * NF1 * 2) * 4;
constexpr size_t OFF_BAR = OFF_CV + al256(CV_BYTES);
constexpr size_t BAR_BYTES = 3456 * 4;
constexpr size_t OFF_XB = OFF_BAR + al256(BAR_BYTES);
constexpr size_t OFF_P = OFF_XB + al256((size_t)TC * 1024 * 2);
constexpr size_t OFF_KAT = OFF_P + al256((size_t)TC * 2048 * 2);
constexpr size_t OFF_VAT = OFF_KAT + al256((size_t)TC * 256 * 2);
constexpr size_t OFF_VBT = OFF_VAT + al256((size_t)TC * 512 * 2);
constexpr size_t OFF_LR = OFF_VBT + al256((size_t)TC * 512 * 2);
constexpr size_t OFF_MIX = OFF_LR + al256((size_t)TC * 32 * 4);
constexpr size_t OFF_Y1 = OFF_MIX + al256((size_t)TC * 1024 * 2);
constexpr size_t OFF_Y1B = OFF_Y1 + al256((size_t)TC * 1024 * 4);
constexpr size_t OFF_ST1 = OFF_Y1B + al256((size_t)TC * 1024 * 2);
constexpr size_t OFF_ST2 = OFF_ST1 + al256((size_t)TC * 32 * 4);
constexpr size_t OFF_DEC = OFF_ST2 + al256((size_t)TC * 32 * 4);
constexpr size_t WS_END = OFF_DEC + al256((size_t)CHB * 4 * 32 * 2 * 64 * 4);
constexpr size_t OFF_H = OFF_P;
constexpr size_t OFF_BC = OFF_Y1;
constexpr size_t OFF_DS = OFF_Y1B;
static_assert((size_t)TC * KF2 * 2 <= OFF_LR - OFF_P, "H does not fit its alias");
static_assert((size_t)CHB * 4 * 32 * 2 * 8192 * 2 <= (size_t)TC * 1024 * 2, "DS does not fit its alias");

struct Params {
    const float *xp, *xs, *w_in, *gw2, *gb, *gng, *rpb, *w_out, *ln1g, *ln1b, *wf1, *wf2, *ln2g, *ln2b;
    float* out; unsigned char* ws;
};

typedef __bf16 bf16x2_t __attribute__((ext_vector_type(2)));
typedef float f32x2_t __attribute__((ext_vector_type(2)));
__device__ __forceinline__ unsigned cvt_pk_bf16(float lo, float hi) { const f32x2_t f = {lo, hi}; const bf16x2_t v = __builtin_convertvector(f, bf16x2_t); return __builtin_bit_cast(unsigned, v); }
__device__ __forceinline__ bf16_t f2bf(float x) { return (bf16_t)(cvt_pk_bf16(x, 0.f) & 0xffffu); }
__device__ __forceinline__ float bf2f(bf16_t h) { return __uint_as_float(((unsigned)h) << 16); }
__device__ __forceinline__ float lo_bf(unsigned x) { return __uint_as_float(x << 16); }
__device__ __forceinline__ float hi_bf(unsigned x) { return __uint_as_float(x & 0xffff0000u); }
__device__ __forceinline__ float silu_f(float x) { return x * __builtin_amdgcn_rcpf(1.0f + __expf(-x)); }
__device__ __forceinline__ void row_stats(const float* st, int row, int fq, float& mu, float& rs) {
    const f32x4 a = *(const f32x4*)(st + (size_t)row * 32 + fq * 8), b = *(const f32x4*)(st + (size_t)row * 32 + fq * 8 + 4);
    float s = (a[0] + a[2]) + (b[0] + b[2]), q = (a[1] + a[3]) + (b[1] + b[3]);
    s += __shfl_xor(s, 16); s += __shfl_xor(s, 32); q += __shfl_xor(q, 16); q += __shfl_xor(q, 32);
    mu = s * (1.0f / 1024.0f); const float var = fmaxf(q * (1.0f / 1024.0f) - mu * mu, 0.f); rs = rsqrtf(var + LN_EPS);
}

__device__ __forceinline__ int opaque_tid() { int t = threadIdx.x; asm volatile("" : "+v"(t)); return t; }
__device__ __forceinline__ const float* xrow_ptr(const float* xp, const float* xs, size_t grow) {
    return grow < (size_t)NPROMPT_ROWS ? xp + grow * DM : xs + (grow - NPROMPT_ROWS) * DM;
}
namespace pg8 {
constexpr int BM = 256, BK = 64, HALF = 128, HTB = HALF * BK * 2, STAGE_BYTES = 8 * HTB, NXCD = 8, WGM = 8;
__host__ __device__ __forceinline__ int lds_byte(int r, int c) { const int st = (r >> 4) * 2 + (c >> 5), rr = r & 15, cc = c & 31, ob = rr * 64 + cc * 2; return st * 1024 + (ob ^ (((ob >> 9) & 1) << 5)); }
__host__ __device__ __forceinline__ void stage_rc(int b, int& R, int& C) { const int st = b / 1024, sb = b % 1024, swz = sb ^ (((sb >> 9) & 1) << 5); R = (st >> 1) * 16 + swz / 64; C = (st & 1) * 32 + (swz % 64) / 2; }
__host__ __device__ __forceinline__ int perm32(int rho) { const int n = rho >> 4, i = rho & 15; return 8 * (i >> 2) + 4 * n + (i & 3); }
struct Unit { int pm, pn; };
struct Gemm { const bf16_t* A; const bf16_t* Bt; int M, N, K; };
struct StaticOrder {
    int nM, nN, nwg, G, c;
    __host__ __device__ void init(int M, int N, int G_, int c_) { nM = M / BM; nN = N / BM; nwg = nM * nN; G = G_; c = c_; }
    __host__ __device__ bool next(int i, Unit& u) const {
        const long L = (long)i * G + c; if (L >= nwg) return false;
        int wgid = (int)L; { const int q = nwg / NXCD, r = nwg % NXCD, xcd = wgid % NXCD, off = wgid / NXCD; wgid = (xcd < r ? xcd * (q + 1) : r * (q + 1) + (xcd - r) * q) + off; }
        const int nig = WGM * nN, gid = wgid / nig, fm = gid * WGM, gsz = (nM - fm) < WGM ? (nM - fm) : WGM;
        u.pm = fm + ((wgid % nig) % gsz); u.pn = (wgid % nig) / gsz; return true;
    }
};
template <class Epi>
__device__ __forceinline__ void gemm_phase(LAS unsigned char* lds, const Gemm g, const StaticOrder& S, const Epi& E) {
    const int tid = opaque_tid(), wid = __builtin_amdgcn_readfirstlane(tid >> 6), lane = tid & 63, wr = wid >> 2, wc = wid & 3, fr = lane & 15, fq = lane >> 4;
    const int K = g.K, nt = K / BK;
    unsigned voffA[2], voffB[2];
#pragma unroll
    for (int i = 0; i < 2; ++i) { int R, C; stage_rc(tid * 16 + i * 8192, R, C); const int Rb = Epi::PERM ? ((R & ~31) + perm32(R & 31)) : R;
        voffA[i] = (unsigned)(R * K + C) * 2u; voffB[i] = (unsigned)(Rb * K + C) * 2u; }
    const size_t kstep = (size_t)(BK * 2);
    const size_t hstep = (size_t)HALF * K * 2;
    const size_t tstep = 2 * hstep;
    const unsigned ldsw = (unsigned)wid * 1024u;
    const int aoff = lds_byte(wr * 64 + fr, fq * 8), boff = lds_byte(wc * 32 + fr, fq * 8);
#define PG8_SA(b, h) (((b) * 2 + (h)) * HTB)
#define PG8_SB(b, h) ((4 + (b) * 2 + (h)) * HTB)
#define PG8_STAGE(bufoff, gbase, voff) do { _Pragma("unroll") for (int _i = 0; _i < 2; ++_i) \
        __builtin_amdgcn_global_load_lds((const unsigned*)((const char*)(gbase) + (voff)[_i]), (LAS unsigned*)(lds + (bufoff) + ldsw + _i * 8192), 16, 0, 0); } while (0)
#define PG8_LDA(dst, b, h) do { _Pragma("unroll") for (int m = 0; m < 4; ++m) _Pragma("unroll") for (int k = 0; k < 2; ++k) dst[m][k] = *(const LAS bf16x8*)(lds + PG8_SA(b, h) + aoff + m * 2048 + k * 1024); } while (0)
#define PG8_LDB(dst, b, h) do { _Pragma("unroll") for (int n = 0; n < 2; ++n) _Pragma("unroll") for (int k = 0; k < 2; ++k) dst[n][k] = *(const LAS bf16x8*)(lds + PG8_SB(b, h) + boff + n * 2048 + k * 1024); } while (0)
#define PG8_MMA(ai, bj, At, Bt) do { __builtin_amdgcn_s_setprio(1); _Pragma("unroll") for (int m = 0; m < 4; ++m) _Pragma("unroll") for (int n = 0; n < 2; ++n) _Pragma("unroll") for (int k = 0; k < 2; ++k) \
        acc[ai][bj][m][n] = __builtin_amdgcn_mfma_f32_16x16x32_bf16(Bt[n][k], At[m][k], acc[ai][bj][m][n], 0, 0, 0); __builtin_amdgcn_s_setprio(0); } while (0)
#define PG8_WAIT_V(n) asm volatile("s_waitcnt vmcnt(" #n ")" ::: "memory")
#define PG8_WAIT_L(n) asm volatile("s_waitcnt lgkmcnt(" #n ")" ::: "memory")
#define PG8_BAR __builtin_amdgcn_s_barrier()
#define PG8_SCHED __builtin_amdgcn_sched_barrier(0)
    Unit cur, nxt; int ui = 0;
    if (!S.next(0, cur)) return;
    f32x4 acc[2][2][4][2];
#pragma unroll
    for (int a = 0; a < 2; ++a)
#pragma unroll
        for (int b = 0; b < 2; ++b)
#pragma unroll
            for (int m = 0; m < 4; ++m)
#pragma unroll
                for (int n = 0; n < 2; ++n) acc[a][b][m][n] = (f32x4){0.f, 0.f, 0.f, 0.f};
    bf16x8 At[4][2], B0[2][2], B1[2][2];
    const char* cA = (const char*)g.A + (size_t)cur.pm * tstep; const char* cB = (const char*)g.Bt + (size_t)cur.pn * tstep;
    PG8_STAGE(PG8_SB(0, 0), cB, voffB); PG8_STAGE(PG8_SA(0, 0), cA, voffA); PG8_STAGE(PG8_SB(0, 1), cB + hstep, voffB); PG8_STAGE(PG8_SA(0, 1), cA + hstep, voffA);
    if (wr == 1) PG8_BAR;
    PG8_WAIT_V(4); PG8_BAR;
    PG8_STAGE(PG8_SB(1, 0), cB + kstep, voffB); PG8_STAGE(PG8_SA(1, 0), cA + kstep, voffA); PG8_STAGE(PG8_SB(1, 1), cB + hstep + kstep, voffB);
    PG8_WAIT_V(6); PG8_BAR;
    for (;;) {
        const bool has_next = S.next(ui + 1, nxt);
        const char* nA = has_next ? (const char*)g.A + (size_t)nxt.pm * tstep : cA; const char* nB = has_next ? (const char*)g.Bt + (size_t)nxt.pn * tstep : cB;
        if constexpr (Epi::PREFETCH) E.prefetch(cur, wid, lane, lds);
        for (int t = 0; t < nt; t += 2) {
            const bool last = (t == nt - 2);
            const char* a1 = cA + (size_t)(t + 1) * kstep;
            const char* a2 = last ? nA : cA + (size_t)(t + 2) * kstep; const char* b2 = last ? nB : cB + (size_t)(t + 2) * kstep;
            const char* a3 = a2 + kstep; const char* b3 = b2 + kstep;
            PG8_LDB(B0, 0, 0); PG8_SCHED; PG8_LDA(At, 0, 0); PG8_STAGE(PG8_SA(1, 1), a1 + hstep, voffA);
            PG8_WAIT_L(8); PG8_BAR; PG8_WAIT_L(0); PG8_MMA(0, 0, At, B0); PG8_BAR; PG8_SCHED;
            PG8_LDB(B1, 0, 1); PG8_STAGE(PG8_SB(0, 0), b2, voffB);
            PG8_BAR; PG8_WAIT_L(0); PG8_MMA(0, 1, At, B1); PG8_BAR;
            PG8_LDA(At, 0, 1); PG8_STAGE(PG8_SA(0, 0), a2, voffA);
            PG8_BAR; PG8_WAIT_L(0); PG8_MMA(1, 0, At, B0); PG8_BAR; PG8_SCHED;
            PG8_STAGE(PG8_SB(0, 1), b2 + hstep, voffB);
            PG8_WAIT_V(6); PG8_BAR; PG8_MMA(1, 1, At, B1); PG8_BAR;
            PG8_LDB(B0, 1, 0); PG8_SCHED; PG8_LDA(At, 1, 0); PG8_STAGE(PG8_SA(0, 1), a2 + hstep, voffA);
            PG8_WAIT_L(8); PG8_BAR; PG8_WAIT_L(0); PG8_MMA(0, 0, At, B0); PG8_BAR; PG8_SCHED;
            PG8_LDB(B1, 1, 1); PG8_STAGE(PG8_SB(1, 0), b3, voffB);
            PG8_BAR; PG8_WAIT_L(0); PG8_MMA(0, 1, At, B1); PG8_BAR;
            PG8_LDA(At, 1, 1); PG8_STAGE(PG8_SA(1, 0), a3, voffA);
            PG8_BAR; PG8_WAIT_L(0); PG8_MMA(1, 0, At, B0); PG8_BAR; PG8_SCHED;
            PG8_STAGE(PG8_SB(1, 1), b3 + hstep, voffB);
            PG8_WAIT_V(6); PG8_BAR; PG8_MMA(1, 1, At, B1); PG8_BAR;
        }
        E(acc, cur, wr, wc, fr, fq);
        if (!has_next) break;
#pragma unroll
        for (int a = 0; a < 2; ++a)
#pragma unroll
            for (int b = 0; b < 2; ++b)
#pragma unroll
                for (int m = 0; m < 4; ++m)
#pragma unroll
                    for (int n = 0; n < 2; ++n) acc[a][b][m][n] = (f32x4){0.f, 0.f, 0.f, 0.f};
        cur = nxt; cA = nA; cB = nB; ++ui;
    }
    PG8_WAIT_V(0);
    if (wr == 0) PG8_BAR;
    PG8_BAR;
#undef PG8_SA
#undef PG8_SB
#undef PG8_STAGE
#undef PG8_LDA
#undef PG8_LDB
#undef PG8_MMA
#undef PG8_WAIT_V
#undef PG8_WAIT_L
#undef PG8_BAR
#undef PG8_SCHED
}
}
using pg8::Unit;

__device__ __forceinline__ u32x4 pack8(const f32x4 a, const f32x4 b) { u32x4 w; w.x = cvt_pk_bf16(a[0], a[1]); w.y = cvt_pk_bf16(a[2], a[3]); w.z = cvt_pk_bf16(b[0], b[1]); w.w = cvt_pk_bf16(b[2], b[3]); return w; }
__device__ __forceinline__ void store_T8(bf16_t* p, const f32x4 a, const f32x4 b, const int odd) {
    bf16_t* q = odd ? p + 4 * (size_t)SEQ - 1 : p;
#pragma unroll
    for (int j = 0; j < 4; ++j) {
        const float pa = __shfl_xor(a[j], 1), pb = __shfl_xor(b[j], 1);
        *(unsigned*)(q + (size_t)j * SEQ) = odd ? cvt_pk_bf16(pb, b[j]) : cvt_pk_bf16(a[j], pa);
    }
}

struct EpiProj {
    static constexpr bool PERM = true, PREFETCH = false;
    bf16_t *P, *KAT, *VAT, *VBT; float* LR;
    const float *st, *c1, *c2;
    __device__ __forceinline__ void operator()(const f32x4 (&acc)[2][2][4][2], const Unit& u, int wr, int wc, int fr_, int fq_) const {
        int fr = fr_, fq = fq_; asm volatile("" : "+v"(fr), "+v"(fq));
        const int pn = u.pn, lc = wc * 32 + fq * 8, bl = u.pm >> 3, tok0 = (u.pm & 7) * 256;
        f32x4 c1v[2][2], c2v[2][2];
#pragma unroll
        for (int bj = 0; bj < 2; ++bj)
#pragma unroll
            for (int n = 0; n < 2; ++n) {
                if (st) { c1v[bj][n] = *(const f32x4*)(c1 + pn * 256 + bj * 128 + lc + 4 * n); c2v[bj][n] = *(const f32x4*)(c2 + pn * 256 + bj * 128 + lc + 4 * n); }
                else { c1v[bj][n] = (f32x4){0.f, 0.f, 0.f, 0.f}; c2v[bj][n] = (f32x4){0.f, 0.f, 0.f, 0.f}; } }
        const bool isT = (pn == 1) || (pn == 2) || (pn == 3) || (pn == 10) || (pn == 11);
        const bool isP = !(pn == 2 || pn == 3 || pn >= 10);
        const int pcol0 = (pn < 2 ? pn : pn - 2) * 256;
        bf16_t* tb[2];
#pragma unroll
        for (int bj = 0; bj < 2; ++bj) { const int col = bj * 128 + lc;
            if (pn == 1) tb[bj] = KAT + ((size_t)(bl * 4 + (col >> 6)) * 64 + (col & 63)) * SEQ;
            else if (pn < 4) { const int cv = (pn - 2) * 256 + col; tb[bj] = VAT + ((size_t)(bl * 4 + (cv >> 7)) * 128 + (cv & 127)) * SEQ; }
            else { const int cv = (pn - 10) * 256 + col; tb[bj] = VBT + ((size_t)(bl * 8 + (cv >> 6)) * 64 + (cv & 63)) * SEQ; } }
#pragma unroll
        for (int ai = 0; ai < 2; ++ai)
#pragma unroll
            for (int m = 0; m < 4; ++m) {
                const int rt = ai * 128 + m * 16 + wr * 64 + fr, grow = u.pm * 256 + rt, tok = tok0 + rt;
                float mu = 0.f, rs = 1.f; if (st) row_stats(st, grow, fq, mu, rs);
#pragma unroll
                for (int bj = 0; bj < 2; ++bj) {
                    const f32x4 v0 = (acc[ai][bj][m][0] - mu * c1v[bj][0]) * rs + c2v[bj][0];
                    const f32x4 v1 = (acc[ai][bj][m][1] - mu * c1v[bj][1]) * rs + c2v[bj][1];
                    const int col = bj * 128 + lc;
                    if (pn == 12) { if (col < 32) { *(f32x4*)(LR + (size_t)grow * 32 + col) = v0; *(f32x4*)(LR + (size_t)grow * 32 + col + 4) = v1; } }
                    else {
                        if (isP) *(u32x4*)(P + (size_t)grow * 2048 + pcol0 + col) = pack8(v0, v1);
                        if (isT) store_T8(tb[bj] + tok, v0, v1, fr & 1);
                    }
                }
            }
    }
};

constexpr int LDS_PF_OFF = 128 * 1024;
template <int LINES_PER_ROW>
__device__ __forceinline__ void prefetch_tile(const char* tile, size_t row_pitch, int wid, int lane, LAS unsigned char* lds) {
    constexpr int ROWS_PER_INSTR = 64 / LINES_PER_ROW, NINSTR = 32 / ROWS_PER_INSTR;
#pragma unroll
    for (int i = 0; i < NINSTR; ++i) { const int row = 32 * wid + ROWS_PER_INSTR * i + lane / LINES_PER_ROW, line = lane % LINES_PER_ROW;
        __builtin_amdgcn_global_load_lds((const unsigned*)(tile + (size_t)row * row_pitch + line * 128), (LAS unsigned*)(lds + LDS_PF_OFF + wid * 256), 4, 0, 0); }
}

struct EpiOut {
    static constexpr bool PERM = true, PREFETCH = true;
    __device__ __forceinline__ void prefetch(const Unit& u, int wid, int lane, LAS unsigned char* lds) const {
        if (st2) prefetch_tile<4>((const char*)(xres + (size_t)u.pm * 256 * 1024 + u.pn * 256), 2048, wid, lane, lds);
        else prefetch_tile<8>((const char*)(xrow_ptr(xp, xs, grow0 + (size_t)u.pm * 256) + u.pn * 256), 4096, wid, lane, lds);
    }
    const bf16_t* xres; const float *xp, *xs; size_t grow0; const float *st2, *g2, *b2;
    bf16_t* Y1B; float* st1;
    __device__ __forceinline__ void operator()(const f32x4 (&acc)[2][2][4][2], const Unit& u, int wr, int wc, int fr_, int fq_) const {
        int fr = fr_, fq = fq_; asm volatile("" : "+v"(fr), "+v"(fq));
        const int lc = wc * 32 + fq * 8;
        const float* xb = xrow_ptr(xp, xs, grow0 + (size_t)u.pm * 256) - (size_t)u.pm * 256 * 1024;
#pragma unroll
        for (int ai = 0; ai < 2; ++ai)
#pragma unroll
            for (int m = 0; m < 4; ++m) {
                const int grow = u.pm * 256 + ai * 128 + m * 16 + wr * 64 + fr;
                float mu = 0.f, rs = 1.f; if (st2) row_stats(st2, grow, fq, mu, rs);
                float s = 0.f, ss = 0.f;
#pragma unroll
                for (int bj = 0; bj < 2; ++bj) {
                    const int col = u.pn * 256 + bj * 128 + lc; const size_t off = (size_t)grow * 1024 + col;
                    f32x4 x0, x1;
                    if (st2) { const u32x4 w = *(const u32x4*)(xres + off);
                        x0 = (f32x4){lo_bf(w.x), hi_bf(w.x), lo_bf(w.y), hi_bf(w.y)}; x1 = (f32x4){lo_bf(w.z), hi_bf(w.z), lo_bf(w.w), hi_bf(w.w)};
                        x0 = (x0 - mu) * rs * *(const f32x4*)(g2 + col) + *(const f32x4*)(b2 + col); x1 = (x1 - mu) * rs * *(const f32x4*)(g2 + col + 4) + *(const f32x4*)(b2 + col + 4); }
                    else { x0 = *(const f32x4*)(xb + off); x1 = *(const f32x4*)(xb + off + 4); }
                    const f32x4 y0 = x0 * ALPHA + acc[ai][bj][m][0], y1 = x1 * ALPHA + acc[ai][bj][m][1];
                    *(u32x4*)(Y1B + off) = pack8(y0, y1);
                    s += (y0[0] + y0[1]) + (y0[2] + y0[3]) + (y1[0] + y1[1]) + (y1[2] + y1[3]);
                    ss += (y0[0] * y0[0] + y0[1] * y0[1]) + (y0[2] * y0[2] + y0[3] * y0[3]) + (y1[0] * y1[0] + y1[1] * y1[1]) + (y1[2] * y1[2] + y1[3] * y1[3]);
                }
                s += __shfl_xor(s, 16); s += __shfl_xor(s, 32); ss += __shfl_xor(ss, 16); ss += __shfl_xor(ss, 32);
                if (fq == 0) { f32x2_t o2 = {s, ss}; *(f32x2_t*)(st1 + (size_t)grow * 32 + (u.pn * 4 + wc) * 2) = o2; }
            }
    }
};

struct EpiF1 {
    static constexpr bool PERM = true, PREFETCH = false;
    const float *st1, *c1, *c2; bf16_t* H;
    __device__ __forceinline__ void operator()(const f32x4 (&acc)[2][2][4][2], const Unit& u, int wr, int wc, int fr_, int fq_) const {
        int fr = fr_, fq = fq_; asm volatile("" : "+v"(fr), "+v"(fq));
        const int lc = wc * 32 + fq * 8;
        f32x4 c1v[2][2], c2v[2][2];
#pragma unroll
        for (int bj = 0; bj < 2; ++bj)
#pragma unroll
            for (int n = 0; n < 2; ++n) { c1v[bj][n] = *(const f32x4*)(c1 + u.pn * 256 + bj * 128 + lc + 4 * n); c2v[bj][n] = *(const f32x4*)(c2 + u.pn * 256 + bj * 128 + lc + 4 * n); }
#pragma unroll
        for (int ai = 0; ai < 2; ++ai)
#pragma unroll
            for (int m = 0; m < 4; ++m) {
                const int grow = u.pm * 256 + ai * 128 + m * 16 + wr * 64 + fr;
                float mu, rs; row_stats(st1, grow, fq, mu, rs);
                f32x4 h[2];
#pragma unroll
                for (int n = 0; n < 2; ++n) {
                    const f32x4 g = (acc[ai][0][m][n] - mu * c1v[0][n]) * rs + c2v[0][n];
                    const f32x4 up = (acc[ai][1][m][n] - mu * c1v[1][n]) * rs + c2v[1][n];
#pragma unroll
                    for (int j = 0; j < 4; ++j) h[n][j] = silu_f(g[j]) * up[j];
                }
                *(u32x4*)(H + (size_t)grow * KF2 + u.pn * 128 + lc) = pack8(h[0], h[1]);
            }
    }
};

struct EpiF2 {
    static constexpr bool PERM = true, PREFETCH = true;
    __device__ __forceinline__ void prefetch(const Unit& u, int wid, int lane, LAS unsigned char* lds) const {
        prefetch_tile<4>((const char*)(Y1B + (size_t)u.pm * 256 * 1024 + u.pn * 256), 2048, wid, lane, lds);
    }
    const bf16_t* Y1B; const float *st1, *g1, *b1; float* OUT; bf16_t* XB; float* st2;
    __device__ __forceinline__ void operator()(const f32x4 (&acc)[2][2][4][2], const Unit& u, int wr, int wc, int fr_, int fq_) const {
        int fr = fr_, fq = fq_; asm volatile("" : "+v"(fr), "+v"(fq));
        const int lc = wc * 32 + fq * 8;
#pragma unroll
        for (int ai = 0; ai < 2; ++ai)
#pragma unroll
            for (int m = 0; m < 4; ++m) {
                const int grow = u.pm * 256 + ai * 128 + m * 16 + wr * 64 + fr;
                float mu, rs; row_stats(st1, grow, fq, mu, rs);
                float s = 0.f, ss = 0.f;
#pragma unroll
                for (int bj = 0; bj < 2; ++bj) {
                    const int col = u.pn * 256 + bj * 128 + lc; const size_t off = (size_t)grow * 1024 + col;
                    const u32x4 w = *(const u32x4*)(Y1B + off);
                    f32x4 x0 = (f32x4){lo_bf(w.x), hi_bf(w.x), lo_bf(w.y), hi_bf(w.y)}, x1 = (f32x4){lo_bf(w.z), hi_bf(w.z), lo_bf(w.w), hi_bf(w.w)};
                    x0 = (x0 - mu) * rs * *(const f32x4*)(g1 + col) + *(const f32x4*)(b1 + col); x1 = (x1 - mu) * rs * *(const f32x4*)(g1 + col + 4) + *(const f32x4*)(b1 + col + 4);
                    const f32x4 y0 = x0 * ALPHA + acc[ai][bj][m][0], y1 = x1 * ALPHA + acc[ai][bj][m][1];
                    *(u32x4*)(XB + off) = pack8(y0, y1);
                    s += (y0[0] + y0[1]) + (y0[2] + y0[3]) + (y1[0] + y1[1]) + (y1[2] + y1[3]);
                    ss += (y0[0] * y0[0] + y0[1] * y0[1]) + (y0[2] * y0[2] + y0[3] * y0[3]) + (y1[0] * y1[0] + y1[1] * y1[1]) + (y1[2] * y1[2] + y1[3] * y1[3]);
                }
                s += __shfl_xor(s, 16); s += __shfl_xor(s, 32); ss += __shfl_xor(ss, 16); ss += __shfl_xor(ss, 32);
                if (fq == 0) { f32x2_t o2 = {s, ss}; *(f32x2_t*)(st2 + (size_t)grow * 32 + (u.pn * 4 + wc) * 2) = o2; }
            }
    }
};

struct MapIn { __device__ static int src(int n) { return n < 1536 ? n : (n < 3072 ? n + 32 : (n < 3104 ? n - 3072 + 1536 : -1)); }
               __device__ static float scale(int n) { return (n < 256 || (n >= 1536 && n < 2048)) ? 0.125f : 1.0f; } };
struct MapId { __device__ static int src(int n) { return n; } __device__ static float scale(int) { return 1.0f; } };
struct MapF1 { __device__ static int src(int n) { const int t = n >> 8, r = n & 255; return r < 128 ? t * 128 + r : 2816 + t * 128 + (r - 128); } __device__ static float scale(int) { return 1.0f; } };

template <class Map>
__device__ __forceinline__ void wt_unit(LAS float* lf, const float* W, int ldw, int K, bf16_t* Wt, int kt, int nt, const float* g, const float* b, float* c1, float* c2) {
    const int tid = opaque_tid();
    {   const int nl = tid & 63, n = nt * 64 + nl, src = Map::src(n); const float sc = Map::scale(n);
#pragma unroll
        for (int i = 0; i < 8; ++i) { const int kl = (tid >> 6) + 8 * i; lf[kl * 65 + nl] = src >= 0 ? W[(size_t)(kt * 64 + kl) * ldw + src] * sc : 0.f; } }
    __syncthreads();
    {   const int nl = tid >> 3, ks = (tid & 7) * 8, n = nt * 64 + nl; float v[8]; float s1 = 0.f, s2 = 0.f;
#pragma unroll
        for (int j = 0; j < 8; ++j) { const float w = lf[(ks + j) * 65 + nl]; const int k = kt * 64 + ks + j; const float gv = g ? g[k] : 1.0f; const float bv = b ? b[k] : 0.f;
            const float r = bf2f(f2bf(w * gv)); v[j] = r; s1 += r; s2 += w * bv; }
        u32x4 pk; pk.x = cvt_pk_bf16(v[0], v[1]); pk.y = cvt_pk_bf16(v[2], v[3]); pk.z = cvt_pk_bf16(v[4], v[5]); pk.w = cvt_pk_bf16(v[6], v[7]);
        *(u32x4*)(Wt + (size_t)n * K + kt * 64 + ks) = pk;
        if (c1) { s1 += __shfl_xor(s1, 1); s1 += __shfl_xor(s1, 2); s1 += __shfl_xor(s1, 4); s2 += __shfl_xor(s2, 1); s2 += __shfl_xor(s2, 2); s2 += __shfl_xor(s2, 4);
            if ((tid & 7) == 0) { atomicAdd(c1 + n, s1); atomicAdd(c2 + n, s2); } } }
    __syncthreads();
}

__device__ __forceinline__ void prologue_weights(const Params& p, LAS unsigned char* lds) {
    LAS float* lf = (LAS float*)lds;
    unsigned char* ws = p.ws;
    float* cv = (float*)(ws + OFF_CV);
    float *c1in = cv, *c2in = cv + 2 * NPROJ, *c1f1 = cv + 4 * NPROJ, *c2f1 = cv + 4 * NPROJ + 2 * NF1;
    for (int u = blockIdx.x; u < 6400; u += gridDim.x) {
        if (u < 1664) { const int l = u / 832, r = u % 832, kt = r / 52, nt = r % 52;
            wt_unit<MapIn>(lf, p.w_in + (size_t)l * DM * 3104, 3104, DM, (bf16_t*)(ws + OFF_WIN) + (size_t)l * NPROJ * DM, kt, nt,
                           l ? p.ln2g : nullptr, l ? p.ln2b : nullptr, l ? c1in + NPROJ : nullptr, l ? c2in + NPROJ : nullptr); }
        else if (u < 2176) { const int v = u - 1664, l = v / 256, r = v % 256, kt = r / 16, nt = r % 16;
            wt_unit<MapId>(lf, p.w_out + (size_t)l * DM * DM, DM, DM, (bf16_t*)(ws + OFF_WOUT) + (size_t)l * DM * DM, kt, nt, nullptr, nullptr, nullptr, nullptr); }
        else if (u < 4992) { const int v = u - 2176, l = v / 1408, r = v % 1408, kt = r / 88, nt = r % 88;
            wt_unit<MapF1>(lf, p.wf1 + (size_t)l * DM * NF1, NF1, DM, (bf16_t*)(ws + OFF_WF1) + (size_t)l * NF1 * DM, kt, nt,
                           p.ln1g + l * DM, p.ln1b + l * DM, c1f1 + l * NF1, c2f1 + l * NF1); }
        else { const int v = u - 4992, l = v / 704, r = v % 704, kt = r / 16, nt = r % 16;
            wt_unit<MapId>(lf, p.wf2 + (size_t)l * KF2 * DM, DM, KF2, (bf16_t*)(ws + OFF_WF2) + (size_t)l * DM * KF2, kt, nt, nullptr, nullptr, nullptr, nullptr); }
    }
}

__device__ __forceinline__ void convert_x(const float* xp, const float* xs, size_t grow0, bf16_t* XB) {
    const size_t n8 = (size_t)TC * DM / 8;
    for (size_t i = (size_t)blockIdx.x * 512 + opaque_tid(); i < n8; i += (size_t)gridDim.x * 512) {
        const float* x = xrow_ptr(xp, xs, grow0 + (i >> 7)) + (i & 127) * 8;
        const f32x4 a = *(const f32x4*)x, b = *(const f32x4*)(x + 4);
        *(u32x4*)(XB + i * 8) = pack8(a, b);
    }
}
__device__ __forceinline__ void final_ln(float* out, const bf16_t* y, const float* st2, const float* g, const float* b) {
    const int tid = opaque_tid(), lane = tid & 63, wv = tid >> 6;
    for (int row = blockIdx.x * 8 + wv; row < TC; row += gridDim.x * 8) {
        const f32x2_t pr = *(const f32x2_t*)(st2 + (size_t)row * 32 + (lane & 15) * 2);
        float s = pr[0], q = pr[1];
#pragma unroll
        for (int d = 1; d < 16; d <<= 1) { s += __shfl_xor(s, d); q += __shfl_xor(q, d); }
        const float mu = s * (1.0f / 1024.0f), rs = rsqrtf(fmaxf(q * (1.0f / 1024.0f) - mu * mu, 0.f) + LN_EPS);
#pragma unroll
        for (int k = 0; k < 2; ++k) { const int c8 = (k * 64 + lane) * 8; const u32x4 w = *(const u32x4*)(y + (size_t)row * 1024 + c8);
            const f32x4 x0 = (f32x4){lo_bf(w.x), hi_bf(w.x), lo_bf(w.y), hi_bf(w.y)}, x1 = (f32x4){lo_bf(w.z), hi_bf(w.z), lo_bf(w.w), hi_bf(w.w)};
            float* po = out + (size_t)row * 1024 + c8;
            *(f32x4*)po = (x0 - mu) * rs * *(const f32x4*)(g + c8) + *(const f32x4*)(b + c8);
            *(f32x4*)(po + 4) = (x1 - mu) * rs * *(const f32x4*)(g + c8 + 4) + *(const f32x4*)(b + c8 + 4); }
    }
}
__device__ __forceinline__ void zero_f32(float* p, size_t n) {
    for (size_t i = (size_t)blockIdx.x * 512 + opaque_tid(); i < n; i += (size_t)gridDim.x * 512) p[i] = 0.f;
}

__device__ __forceinline__ float log_sigmoid_f(float z) { return fminf(z, 0.f) - log1pf(expf(-fabsf(z))); }

typedef __attribute__((ext_vector_type(2))) float f32x2;
__device__ __forceinline__ f32x4 mfma16(bf16x8 a, bf16x8 b, f32x4 c) { return __builtin_amdgcn_mfma_f32_16x16x32_bf16(a, b, c, 0, 0, 0); }
__device__ __forceinline__ bf16x8 scale8(bf16x8 raw, f32x4 e0, f32x4 e1) {
    const u32x4 r = __builtin_bit_cast(u32x4, raw); u32x4 o;
    o.x = cvt_pk_bf16(lo_bf(r.x) * e0[0], hi_bf(r.x) * e0[1]); o.y = cvt_pk_bf16(lo_bf(r.y) * e0[2], hi_bf(r.y) * e0[3]);
    o.z = cvt_pk_bf16(lo_bf(r.z) * e1[0], hi_bf(r.z) * e1[1]); o.w = cvt_pk_bf16(lo_bf(r.w) * e1[2], hi_bf(r.w) * e1[3]);
    return __builtin_bit_cast(bf16x8, o);
}
constexpr int HALF_LDS = 45056;
constexpr int ROWP = 68;
#define MEMBAR() asm volatile("" ::: "memory")

__device__ __forceinline__ float log_sigmoid_fast(float z) {
    const float e = __builtin_amdgcn_exp2f(-1.44269504088896f * fabsf(z));
    return fminf(z, 0.f) - 0.693147180559945f * __builtin_amdgcn_logf(1.0f + e);
}
__device__ __forceinline__ void gla_gates(const LAS float* lrs, const float* w2, const float* gbias, int h, int d, int w, float (&pf)[16], float (&sb)[16]) {
    float wf[16], wb[16];
#pragma unroll
    for (int r = 0; r < 16; ++r) { wf[r] = w2[r * 256 + h * 64 + d]; wb[r] = w2[(16 + r) * 256 + h * 64 + d]; }
    const float bf = gbias[h * 64 + d], bb = gbias[256 + h * 64 + d];
#pragma unroll
    for (int j = 0; j < 16; ++j) {
        const LAS float* lr = lrs + (w * 16 + j) * 32;
        f32x2_t z2 = {bf, bb};
#pragma unroll
        for (int r4 = 0; r4 < 4; ++r4) { const f32x4 a = *(const LAS f32x4*)(lr + 4 * r4), b = *(const LAS f32x4*)(lr + 16 + 4 * r4);
#pragma unroll
            for (int q = 0; q < 4; ++q) { const f32x2_t x2 = {a[q], b[q]}, w2v = {wf[4 * r4 + q], wb[4 * r4 + q]}; z2 = __builtin_elementwise_fma(x2, w2v, z2); } }
        pf[j] = log_sigmoid_fast(z2[0]) * (1.0f / 16.0f); sb[j] = log_sigmoid_fast(z2[1]) * (1.0f / 16.0f);
    }
#pragma unroll
    for (int j = 1; j < 16; ++j) pf[j] += pf[j - 1];
#pragma unroll
    for (int j = 14; j >= 0; --j) sb[j] += sb[j + 1];
}

__device__ __forceinline__ void gla_g1(LAS unsigned char* lds, const bf16_t* KAT, const bf16_t* VAT, const float* LR, const float* w2, const float* gbias, bf16_t* DS, float* DEC, float* BC) {
    const int tid = opaque_tid(), half = tid >> 8, t256 = tid & 255, d = tid & 63, lane = tid & 63, fr = lane & 15, g = lane >> 4;
    const int w = __builtin_amdgcn_readfirstlane((tid >> 6) & 3);
    LAS float* tot = (LAS float*)(lds + half * HALF_LDS);
    LAS float* ETf = tot + 512; LAS float* ETb = ETf + 64 * ROWP; LAS float* LRS = ETb + 64 * ROWP;
    for (int it = blockIdx.x; it < CHB * 4 * 32 / 2; it += gridDim.x) {
        const int uid = it * 2 + half, c = uid & 31, h = (uid >> 5) & 3, bl = uid >> 7;
        const size_t row0 = (size_t)bl * SEQ + c * 64;
        const bf16_t* kat = KAT + ((size_t)(bl * 4 + h) * 64) * SEQ + c * 64;
        const bf16_t* vat = VAT + ((size_t)(bl * 4 + h) * 128) * SEQ + c * 64;
        const f32x4 l0 = *(const f32x4*)(LR + row0 * 32 + t256 * 8), l1 = *(const f32x4*)(LR + row0 * 32 + t256 * 8 + 4);
        bf16x8 bfr[2][2], kraw[2][4];
#pragma unroll
        for (int t = 0; t < 2; ++t) {
#pragma unroll
            for (int e = 0; e < 2; ++e) bfr[t][e] = *(const bf16x8*)(vat + (size_t)(16 * (2 * w + e) + fr) * SEQ + 32 * t + 8 * g);
#pragma unroll
            for (int mb = 0; mb < 4; ++mb) kraw[t][mb] = *(const bf16x8*)(kat + (size_t)(16 * mb + fr) * SEQ + 32 * t + 8 * g);
        }
        MEMBAR();
        *(LAS f32x4*)(LRS + t256 * 8) = l0; *(LAS f32x4*)(LRS + t256 * 8 + 4) = l1;
        __syncthreads();
        float pf[16], sb[16];
        gla_gates(LRS, w2, gbias, h, d, w, pf, sb);
        tot[w * 64 + d] = pf[15]; tot[(4 + w) * 64 + d] = sb[0];
        __syncthreads();
        float offf = 0.f, offb = 0.f, totf = 0.f, totb = 0.f;
#pragma unroll
        for (int q = 0; q < 4; ++q) { const float a = tot[q * 64 + d], b = tot[(4 + q) * 64 + d]; totf += a; totb += b; if (q < w) offf += a; if (q > w) offb += b; }
#pragma unroll
        for (int j4 = 0; j4 < 4; ++j4) { f32x4 vf, vb;
#pragma unroll
            for (int jj = 0; jj < 4; ++jj) { vf[jj] = __expf(totf - (offf + pf[j4 * 4 + jj])); vb[jj] = __expf(totb - (offb + sb[j4 * 4 + jj])); }
            *(LAS f32x4*)(ETf + d * ROWP + w * 16 + j4 * 4) = vf; *(LAS f32x4*)(ETb + d * ROWP + w * 16 + j4 * 4) = vb; }
        if (w == 0) { DEC[((size_t)uid * 2 + 0) * 64 + d] = __expf(totf); DEC[((size_t)uid * 2 + 1) * 64 + d] = __expf(totb); }
        {   float* bc = BC + (size_t)uid * 8192 + (w * 16) * 64 + d;
#pragma unroll
            for (int j = 0; j < 16; ++j) { bc[j * 64] = (offf + pf[j]) * 1.44269504088896f; bc[4096 + j * 64] = (offb + sb[j]) * 1.44269504088896f; } }
        __syncthreads();
        f32x4 acc[2][4][2];
#pragma unroll
        for (int a = 0; a < 2; ++a)
#pragma unroll
            for (int b = 0; b < 4; ++b)
#pragma unroll
                for (int e = 0; e < 2; ++e) acc[a][b][e] = (f32x4){0.f, 0.f, 0.f, 0.f};
#pragma unroll
        for (int t = 0; t < 2; ++t) {
#pragma unroll
            for (int mb = 0; mb < 4; ++mb) {
                const LAS float* ef = ETf + (16 * mb + fr) * ROWP + 32 * t + 8 * g; const LAS float* eb = ETb + (16 * mb + fr) * ROWP + 32 * t + 8 * g;
                const bf16x8 af = scale8(kraw[t][mb], *(const LAS f32x4*)ef, *(const LAS f32x4*)(ef + 4)), ab = scale8(kraw[t][mb], *(const LAS f32x4*)eb, *(const LAS f32x4*)(eb + 4));
#pragma unroll
                for (int e = 0; e < 2; ++e) { acc[0][mb][e] = mfma16(af, bfr[t][e], acc[0][mb][e]); acc[1][mb][e] = mfma16(ab, bfr[t][e], acc[1][mb][e]); }
            }
        }
#pragma unroll
        for (int dir = 0; dir < 2; ++dir)
#pragma unroll
            for (int mb = 0; mb < 4; ++mb)
#pragma unroll
                for (int e = 0; e < 2; ++e) { const f32x4 a = acc[dir][mb][e]; u32x2 o; o.x = cvt_pk_bf16(a[0], a[1]); o.y = cvt_pk_bf16(a[2], a[3]);
                    *(u32x2*)(DS + (((size_t)uid * 2 + dir) * 128 + 16 * (2 * w + e) + fr) * 64 + 16 * mb + 4 * g) = o; }
        __syncthreads();
    }
}

__device__ __forceinline__ void gla_g2(LAS unsigned char* lds, bf16_t* DS, const float* DEC) {
    const int tid = opaque_tid();
    LAS float* dl = (LAS float*)lds;
    for (int it = blockIdx.x; it < CHB * 4 * 2 * 2; it += gridDim.x) {
        const int e = (it & 1) * 512 + tid, bhd = it >> 1, dir = bhd & 1, bh = bhd >> 1;
        {   const int i4 = tid * 4, cc = i4 >> 6, dk = i4 & 63;
            *(LAS f32x4*)(dl + i4) = *(const f32x4*)(DEC + ((size_t)(bh * 32 + cc) * 2 + dir) * 64 + dk); }
        u32x4 dsv[32];
#pragma unroll
        for (int k = 0; k < 32; ++k) { const int c = dir ? 31 - k : k; dsv[k] = *(const u32x4*)(DS + ((size_t)(bh * 32 + c) * 2 + dir) * 8192 + (size_t)e * 8); }
        MEMBAR();
        __syncthreads();
        float S[8];
#pragma unroll
        for (int q = 0; q < 8; ++q) S[q] = 0.f;
#pragma unroll
        for (int k = 0; k < 32; ++k) { const int c = dir ? 31 - k : k;
            const f32x4 d0 = *(const LAS f32x4*)(dl + c * 64 + (e & 7) * 8), d1 = *(const LAS f32x4*)(dl + c * 64 + (e & 7) * 8 + 4);
            u32x4 o; o.x = cvt_pk_bf16(S[0], S[1]); o.y = cvt_pk_bf16(S[2], S[3]); o.z = cvt_pk_bf16(S[4], S[5]); o.w = cvt_pk_bf16(S[6], S[7]);
            *(u32x4*)(DS + ((size_t)(bh * 32 + c) * 2 + dir) * 8192 + (size_t)e * 8) = o;
            S[0] = d0[0] * S[0] + lo_bf(dsv[k].x); S[1] = d0[1] * S[1] + hi_bf(dsv[k].x); S[2] = d0[2] * S[2] + lo_bf(dsv[k].y); S[3] = d0[3] * S[3] + hi_bf(dsv[k].y);
            S[4] = d1[0] * S[4] + lo_bf(dsv[k].z); S[5] = d1[1] * S[5] + hi_bf(dsv[k].z); S[6] = d1[2] * S[6] + lo_bf(dsv[k].w); S[7] = d1[3] * S[7] + hi_bf(dsv[k].w); }
        __syncthreads();
    }
}

constexpr int G3_KRAW = 0, G3_VT = 9216, G3_SF = 27648, G3_SB = 46080, G3_TBF = 64512, G3_TBB = 81920, G3_KIF = 99328, G3_KIB = 108544, G3_RED = 117760;
__device__ __forceinline__ void g3_dma_tile(LAS unsigned char* dst, const unsigned char* src, int row_bytes_src, int D, int ninstr, int wv, int lane) {
    for (int q = wv; q < ninstr; q += 8) { const int C = 64 * q + lane, row = C / (D + 1), pos = min(C - row * (D + 1), D - 1);
        __builtin_amdgcn_global_load_lds((const unsigned*)(src + (size_t)row * row_bytes_src + pos * 16), (LAS unsigned*)(dst + q * 1024), 16, 0, 0); }
}
__device__ __forceinline__ void g3_dma_unit(LAS unsigned char* lds, const bf16_t* P, const bf16_t* VAT, const bf16_t* DS, const float* BC, int uid, int wv, int lane) {
    const int c = uid & 31, h = (uid >> 5) & 3, bl = uid >> 7;
    const size_t row0 = (size_t)bl * SEQ + c * 64;
    g3_dma_tile(lds + G3_KRAW, (const unsigned char*)(P + row0 * 2048 + 256 + h * 64), 4096, 8, 9, wv, lane);
    g3_dma_tile(lds + G3_VT, (const unsigned char*)(VAT + ((size_t)(bl * 4 + h) * 128) * SEQ + c * 64), SEQ * 2, 8, 18, wv, lane);
    g3_dma_tile(lds + G3_SF, (const unsigned char*)(DS + ((size_t)uid * 2 + 0) * 8192), 128, 8, 18, wv, lane);
    g3_dma_tile(lds + G3_SB, (const unsigned char*)(DS + ((size_t)uid * 2 + 1) * 8192), 128, 8, 18, wv, lane);
    g3_dma_tile(lds + G3_TBF, (const unsigned char*)(BC + (size_t)uid * 8192), 256, 16, 17, wv, lane);
    g3_dma_tile(lds + G3_TBB, (const unsigned char*)(BC + (size_t)uid * 8192 + 4096), 256, 16, 17, wv, lane);
}
__device__ __forceinline__ void gla_g3(LAS unsigned char* lds, const bf16_t* P, const bf16_t* VAT, const bf16_t* DS, const float* BC, const float* gn, bf16_t* MIX) {
    const int tid = opaque_tid(), lane = tid & 63, fr = lane & 15, g = lane >> 4;
    const int wv = __builtin_amdgcn_readfirstlane(tid >> 6), rb = wv & 3, dvh = wv >> 2;
    const int iq = 16 * rb + fr;
    const int nun = CHB * 4 * 32;
    int uid = blockIdx.x;
    if (uid < nun) g3_dma_unit(lds, P, VAT, DS, BC, uid, wv, lane);
    for (; uid < nun; uid += gridDim.x) {
        const int c = uid & 31, h = (uid >> 5) & 3, bl = uid >> 7;
        const size_t row0 = (size_t)bl * SEQ + c * 64, qrow = row0 + iq;
        bf16x8 qraw[2]; f32x4 gvv[4]; u32x2 rvv[4];
#pragma unroll
        for (int s2 = 0; s2 < 2; ++s2) qraw[s2] = *(const bf16x8*)(P + qrow * 2048 + h * 64 + 32 * s2 + 8 * g);
#pragma unroll
        for (int mb = 0; mb < 4; ++mb) { const int cc = h * 128 + 16 * (4 * dvh + mb) + 4 * g; gvv[mb] = *(const f32x4*)(gn + cc); rvv[mb] = *(const u32x2*)(P + qrow * 2048 + 512 + cc); }
        asm volatile("s_waitcnt vmcnt(0)" ::: "memory");
        __syncthreads();
        {
            const int j = 8 * wv + (lane >> 3), ch = lane & 7;
            const bf16x8 kr = *(const LAS bf16x8*)(lds + G3_KRAW + (j * 9 + ch) * 16);
            const LAS float* tf = (const LAS float*)(lds + G3_TBF + j * 272 + ch * 32); const LAS float* tb = (const LAS float*)(lds + G3_TBB + j * 272 + ch * 32);
            f32x4 a0 = *(const LAS f32x4*)tf, a1 = *(const LAS f32x4*)(tf + 4), b0 = *(const LAS f32x4*)tb, b1 = *(const LAS f32x4*)(tb + 4);
#pragma unroll
            for (int q = 0; q < 4; ++q) { a0[q] = __builtin_amdgcn_exp2f(-a0[q]); a1[q] = __builtin_amdgcn_exp2f(-a1[q]); b0[q] = __builtin_amdgcn_exp2f(-b0[q]); b1[q] = __builtin_amdgcn_exp2f(-b1[q]); }
            *(LAS bf16x8*)(lds + G3_KIF + (j * 9 + ch) * 16) = scale8(kr, a0, a1); *(LAS bf16x8*)(lds + G3_KIB + (j * 9 + ch) * 16) = scale8(kr, b0, b1);
        }
        bf16x8 qdf[2], qdb[2];
#pragma unroll
        for (int s2 = 0; s2 < 2; ++s2) {
            const LAS float* tf = (const LAS float*)(lds + G3_TBF + iq * 272 + (32 * s2 + 8 * g) * 4); const LAS float* tb = (const LAS float*)(lds + G3_TBB + iq * 272 + (32 * s2 + 8 * g) * 4);
            f32x4 a0 = *(const LAS f32x4*)tf, a1 = *(const LAS f32x4*)(tf + 4), b0 = *(const LAS f32x4*)tb, b1 = *(const LAS f32x4*)(tb + 4);
#pragma unroll
            for (int q = 0; q < 4; ++q) { a0[q] = __builtin_amdgcn_exp2f(a0[q]); a1[q] = __builtin_amdgcn_exp2f(a1[q]); b0[q] = __builtin_amdgcn_exp2f(b0[q]); b1[q] = __builtin_amdgcn_exp2f(b1[q]); }
            qdf[s2] = scale8(qraw[s2], a0, a1); qdb[s2] = scale8(qraw[s2], b0, b1);
        }
        __syncthreads();
        bf16x8 pfrag[2];
#pragma unroll
        for (int t = 0; t < 2; ++t) {
            f32x4 sf[2], sv[2];
#pragma unroll
            for (int u = 0; u < 2; ++u) {
                const int j = 32 * t + 8 * (fr >> 2) + 4 * u + (fr & 3);
                sf[u] = (f32x4){0.f, 0.f, 0.f, 0.f}; sv[u] = (f32x4){0.f, 0.f, 0.f, 0.f};
#pragma unroll
                for (int s2 = 0; s2 < 2; ++s2) {
                    sf[u] = mfma16(*(const LAS bf16x8*)(lds + G3_KIF + (j * 9 + 4 * s2 + g) * 16), qdf[s2], sf[u]);
                    sv[u] = mfma16(*(const LAS bf16x8*)(lds + G3_KIB + (j * 9 + 4 * s2 + g) * 16), qdb[s2], sv[u]);
                }
            }
            f32x4 p0, p1;
#pragma unroll
            for (int ii = 0; ii < 4; ++ii) { const int j0 = 32 * t + 8 * g + ii, j1 = j0 + 4; p0[ii] = (j0 <= iq) ? sf[0][ii] : sv[0][ii]; p1[ii] = (j1 <= iq) ? sf[1][ii] : sv[1][ii]; }
            pfrag[t] = __builtin_bit_cast(bf16x8, pack8(p0, p1));
        }
        f32x4 o[4];
#pragma unroll
        for (int mb = 0; mb < 4; ++mb) o[mb] = (f32x4){0.f, 0.f, 0.f, 0.f};
#pragma unroll
        for (int t = 0; t < 2; ++t)
#pragma unroll
            for (int mb = 0; mb < 4; ++mb) o[mb] = mfma16(*(const LAS bf16x8*)(lds + G3_VT + ((16 * (4 * dvh + mb) + fr) * 9 + 4 * t + g) * 16), pfrag[t], o[mb]);
#pragma unroll
        for (int s2 = 0; s2 < 2; ++s2)
#pragma unroll
            for (int mb = 0; mb < 4; ++mb) {
                o[mb] = mfma16(*(const LAS bf16x8*)(lds + G3_SF + ((16 * (4 * dvh + mb) + fr) * 9 + 4 * s2 + g) * 16), qdf[s2], o[mb]);
                o[mb] = mfma16(*(const LAS bf16x8*)(lds + G3_SB + ((16 * (4 * dvh + mb) + fr) * 9 + 4 * s2 + g) * 16), qdb[s2], o[mb]);
            }
        float ss = 0.f;
#pragma unroll
        for (int mb = 0; mb < 4; ++mb) ss += (o[mb][0] * o[mb][0] + o[mb][1] * o[mb][1]) + (o[mb][2] * o[mb][2] + o[mb][3] * o[mb][3]);
        ss += __shfl_xor(ss, 16); ss += __shfl_xor(ss, 32);
        LAS float* red = (LAS float*)(lds + G3_RED);
        if (g == 0) red[iq * 2 + dvh] = ss;
        __syncthreads();
        if (uid + (int)gridDim.x < nun) g3_dma_unit(lds, P, VAT, DS, BC, uid + (int)gridDim.x, wv, lane);
        const float rstd = rsqrtf((red[iq * 2] + red[iq * 2 + 1]) * (1.0f / 128.0f) + LN_EPS);
#pragma unroll
        for (int mb = 0; mb < 4; ++mb) {
            const int cc = h * 128 + 16 * (4 * dvh + mb) + 4 * g;
            const f32x4 gv = gvv[mb]; const u32x2 rv = rvv[mb];
            const float r0 = silu_f(lo_bf(rv.x)), r1 = silu_f(hi_bf(rv.x)), r2 = silu_f(lo_bf(rv.y)), r3 = silu_f(hi_bf(rv.y));
            u32x2 ov; ov.x = cvt_pk_bf16(o[mb][0] * rstd * gv[0] * r0, o[mb][1] * rstd * gv[1] * r1); ov.y = cvt_pk_bf16(o[mb][2] * rstd * gv[2] * r2, o[mb][3] * rstd * gv[3] * r3);
            *(u32x2*)(MIX + qrow * 1024 + cc) = ov;
        }
    }
    asm volatile("s_waitcnt vmcnt(0)" ::: "memory");
    __syncthreads();
}

constexpr int NAT_K_BYTES = 9 * 64 * 128, NAT_VROW = 73, NAT_V_BYTES = 64 * NAT_VROW * 16, NAT_R_OFF = NAT_K_BYTES + NAT_V_BYTES;
constexpr int NAT_LDS_END = NAT_R_OFF + 8 * 15 * 31 * 4;
__device__ __forceinline__ void nat_dma_k(LAS unsigned char* lds, const bf16_t* P, int wv, int lane, size_t brow, int h, int RB) {
#pragma unroll
    for (int q9 = 0; q9 < 9; ++q9) { const int q = wv + 8 * q9, C = 64 * q + lane, key = C >> 3, slot = C & 7, src = slot ^ ((key ^ (key >> 3)) & 7);
        const int row = min(RB + (key >> 6), 31), tok = row * 64 + (key & 63);
        __builtin_amdgcn_global_load_lds((const unsigned*)(P + (brow + tok) * 2048 + 1536 + h * 64 + src * 8), (LAS unsigned*)(lds + q * 1024), 16, 0, 0); }
}
__device__ __forceinline__ void nat_dma_v(LAS unsigned char* lds, const bf16_t* VBT, int wv, int lane, int bh, int RB) {
    const int pmax = (32 - RB) * 8 - 1;
#pragma unroll
    for (int q10 = 0; q10 < 10; ++q10) { const int q = wv + 8 * q10;
        if (q < NAT_VROW) { const int C = 64 * q + lane, d = C / NAT_VROW, pos = min(C - d * NAT_VROW, min(71, pmax));
            __builtin_amdgcn_global_load_lds((const unsigned*)(VBT + ((size_t)bh * 64 + d) * SEQ + RB * 64 + pos * 8), (LAS unsigned*)(lds + NAT_K_BYTES + q * 1024), 16, 0, 0); } }
}
__device__ __forceinline__ void nat_mfma(LAS unsigned char* lds, const bf16_t* P, const bf16_t* VBT, const float* rpb, bf16_t* MIX) {
    const int tid = opaque_tid(), lane = tid & 63, fr = lane & 15, g = lane >> 4;
    const int wv = __builtin_amdgcn_readfirstlane(tid >> 6);
    LAS float* rl = (LAS float*)(lds + NAT_R_OFF);
    for (int i = tid; i < 8 * 15 * 31; i += 512) rl[i] = rpb[i];
    const int kcl = 8 * (fr >> 2) + (fr & 3);
    const bool xcd_map = (gridDim.x & 7) == 0;
    const int nits = CHB * 8 * 16, kend = xcd_map ? nits / 8 : nits, kstep = xcd_map ? (int)(gridDim.x >> 3) : (int)gridDim.x;
    int k = xcd_map ? (int)(blockIdx.x >> 3) : (int)blockIdx.x;
    if (k < kend) { const int bh = xcd_map ? (k >> 4) * 8 + (int)(blockIdx.x & 7) : (k >> 4), rp = k & 15;
        nat_dma_k(lds, P, wv, lane, (size_t)(bh >> 3) * SEQ, bh & 7, min(max(2 * rp - 4, 0), 24)); }
    for (; k < kend; k += kstep) {
        const int bh = xcd_map ? (k >> 4) * 8 + (int)(blockIdx.x & 7) : (k >> 4), rp = k & 15;
        const int jq = wv & 3, r = rp * 2 + (wv >> 2), h = bh & 7, bl = bh >> 3;
        const int RB = min(max(2 * rp - 4, 0), 24), rs = min(max(r - 4, 0), 24), kb0 = min(max(16 * jq - 8, 0), 32);
        const size_t brow = (size_t)bl * SEQ;
        const size_t qrow = brow + r * 64 + 16 * jq + fr;
        bf16x8 qf[2];
#pragma unroll
        for (int s2 = 0; s2 < 2; ++s2) qf[s2] = *(const bf16x8*)(P + qrow * 2048 + 1024 + h * 64 + 32 * s2 + 8 * g);
        asm volatile("s_waitcnt vmcnt(0)" ::: "memory");
        __syncthreads();
        nat_dma_v(lds, VBT, wv, lane, bh, RB);
        f32x4 sc[8][2];
#pragma unroll
        for (int t = 0; t < 8; ++t)
#pragma unroll
            for (int u = 0; u < 2; ++u) {
                const int kl = (rs - RB + t) * 64 + kb0 + kcl + 4 * u, sw = (kl ^ (kl >> 3)) & 7;
                f32x4 a = (f32x4){0.f, 0.f, 0.f, 0.f};
#pragma unroll
                for (int s2 = 0; s2 < 2; ++s2) a = mfma16(*(const LAS bf16x8*)(lds + kl * 128 + (((s2 * 4 + g) ^ sw) << 4)), qf[s2], a);
                sc[t][u] = a;
            }
        const int qc = 16 * jq + fr, cst = min(max(qc - 8, 0), 48);
        float mx = -3.0e38f;
#pragma unroll
        for (int u = 0; u < 2; ++u)
#pragma unroll
            for (int ii = 0; ii < 4; ++ii) {
                const int kc = kb0 + 8 * g + 4 * u + ii; const bool valid = (kc >= cst) && (kc < cst + 16);
                const int co = min(max(kc - qc + 15, 0), 30);
                const LAS float* rp_ = rl + (h * 15 + rs - r + 7) * 31 + co;
                float bias[8];
#pragma unroll
                for (int t = 0; t < 8; ++t) bias[t] = rp_[t * 31];
#pragma unroll
                for (int t = 0; t < 8; ++t) asm volatile("" : "+v"(bias[t]));
#pragma unroll
                for (int t = 0; t < 8; ++t) { const float v = valid ? sc[t][u][ii] + bias[t] : -1.0e30f; sc[t][u][ii] = v; mx = fmaxf(mx, v); }
            }
        mx = fmaxf(mx, __shfl_xor(mx, 16)); mx = fmaxf(mx, __shfl_xor(mx, 32));
        float sum = 0.f;
        bf16x8 pf[8];
#pragma unroll
        for (int t = 0; t < 8; ++t) {
            f32x4 p0, p1;
#pragma unroll
            for (int ii = 0; ii < 4; ++ii) { p0[ii] = __expf(sc[t][0][ii] - mx); p1[ii] = __expf(sc[t][1][ii] - mx); sum += p0[ii] + p1[ii]; }
            pf[t] = __builtin_bit_cast(bf16x8, pack8(p0, p1));
        }
        sum += __shfl_xor(sum, 16); sum += __shfl_xor(sum, 32);
        const float inv = 1.0f / sum;
        asm volatile("s_waitcnt vmcnt(0)" ::: "memory");
        __syncthreads();
        if (k + kstep < kend) { const int k2 = k + kstep, bh2 = xcd_map ? (k2 >> 4) * 8 + (int)(blockIdx.x & 7) : (k2 >> 4), rp2 = k2 & 15;
            nat_dma_k(lds, P, wv, lane, (size_t)(bh2 >> 3) * SEQ, bh2 & 7, min(max(2 * rp2 - 4, 0), 24)); }
        f32x4 o[4];
#pragma unroll
        for (int mb = 0; mb < 4; ++mb) o[mb] = (f32x4){0.f, 0.f, 0.f, 0.f};
        const int vpos = (rs - RB) * 8 + (kb0 >> 3) + g;
#pragma unroll
        for (int t = 0; t < 8; ++t)
#pragma unroll
            for (int mb = 0; mb < 4; ++mb) o[mb] = mfma16(*(const LAS bf16x8*)(lds + NAT_K_BYTES + (((16 * mb + fr) * NAT_VROW + vpos + 8 * t) << 4)), pf[t], o[mb]);
#pragma unroll
        for (int mb = 0; mb < 4; ++mb) { u32x2 ov; ov.x = cvt_pk_bf16(o[mb][0] * inv, o[mb][1] * inv); ov.y = cvt_pk_bf16(o[mb][2] * inv, o[mb][3] * inv);
            *(u32x2*)(MIX + qrow * 1024 + 512 + h * 64 + 16 * mb + 4 * g) = ov; }
    }
    asm volatile("s_waitcnt vmcnt(0)" ::: "memory");
    __syncthreads();
}

#define XB_TMO      128
#define XB_XCNT(j)  (256  + 64 * (j))
#define XB_XSUB(j)  (1280 + 64 * (j))
#define XB_XGEN(j)  (2304 + 64 * (j))
#define XB_TOP      3328
#define XB_TOPGEN   3392
#define XCD_BAR_WORDS 3456
#define XB_SPIN_CAP (1u << 18)
__device__ __forceinline__ unsigned xb_ld(unsigned* p)              { return __hip_atomic_load(p, __ATOMIC_RELAXED, __HIP_MEMORY_SCOPE_AGENT); }
__device__ __forceinline__ unsigned xb_add(unsigned* p, unsigned v) { return __hip_atomic_fetch_add(p, v, __ATOMIC_RELAXED, __HIP_MEMORY_SCOPE_AGENT); }
__device__ __forceinline__ unsigned xb_xcc_id() { return (unsigned)__builtin_amdgcn_s_getreg((3 << 11) | 20) & 0xFu; }
#define XB_SPIN(cond, bar) do { unsigned _sp = 0; while (cond) { __builtin_amdgcn_s_sleep(1); \
    if ((++_sp & 255u) == 0u) { if (xb_ld(&(bar)[XB_TMO])) break; if (_sp > XB_SPIN_CAP) { atomicAdd(&(bar)[XB_TMO], 1u); break; } } } } while (0)
struct XcdBarrier { unsigned* bar; unsigned x; volatile LAS unsigned* st; };
__device__ __forceinline__ XcdBarrier xcd_barrier_post(unsigned* bar, volatile LAS unsigned* st) {
    XcdBarrier b; b.bar = bar; b.x = xb_xcc_id(); b.st = st;
    if (threadIdx.x == 0) (void)xb_add(&bar[XB_XCNT(b.x)], 1u);
    return b;
}
__device__ __forceinline__ void xcd_barrier_complete(unsigned* bar, unsigned x, unsigned& nloc, unsigned& nx) {
    const unsigned G = gridDim.x * gridDim.y * gridDim.z;
    unsigned sum, cnt, mine, sp = 0u;
    for (;;) {
        sum = 0u; cnt = 0u; mine = 0u;
#pragma unroll
        for (unsigned j = 0; j < 16; ++j) { const unsigned c = xb_ld(&bar[XB_XCNT(j)]); sum += c; cnt += (c > 0u) ? 1u : 0u; mine = (j == x) ? c : mine; }
        if (sum == G) break;
        __builtin_amdgcn_s_sleep(1);
        if ((++sp & 255u) == 0u) { if (xb_ld(&bar[XB_TMO])) break; if (sp > XB_SPIN_CAP) { atomicAdd(&bar[XB_TMO], 1u); break; } }
    }
    nloc = mine > 0u ? mine : 1u; nx = cnt > 0u ? cnt : 1u;
}
__device__ __forceinline__ void xcd_barrier(const XcdBarrier& b) {
    asm volatile("s_waitcnt vmcnt(0)" ::: "memory");
    __syncthreads();
    if (threadIdx.x == 0) {
        unsigned* bar = b.bar;
        __builtin_amdgcn_s_waitcnt(0);
        unsigned nloc = b.st[0], nx = b.st[1];
        if (nloc == 0u) { xcd_barrier_complete(bar, b.x, nloc, nx); b.st[0] = nloc; b.st[1] = nx; }
        const unsigned old = xb_add(&bar[XB_XSUB(b.x)], 1u);
        const unsigned gen = old / nloc;
        if (old + 1u == (gen + 1u) * nloc) {
            __builtin_amdgcn_fence(__ATOMIC_RELEASE, "agent");
            asm volatile("s_waitcnt vmcnt(0)" ::: "memory");
            const unsigned og = xb_add(&bar[XB_TOP], 1u);
            const unsigned tg = og / nx;
            if (og + 1u == (tg + 1u) * nx) xb_add(&bar[XB_TOPGEN], 1u);
            else XB_SPIN(xb_ld(&bar[XB_TOPGEN]) == tg, bar);
            __builtin_amdgcn_fence(__ATOMIC_ACQUIRE, "agent");
            xb_add(&bar[XB_XGEN(b.x)], 1u);
            asm volatile("s_waitcnt vmcnt(0)" ::: "memory");
        } else {
            XB_SPIN(xb_ld(&bar[XB_XGEN(b.x)]) == gen, bar);
            __builtin_amdgcn_fence(__ATOMIC_ACQUIRE, "agent");
            asm volatile("s_waitcnt vmcnt(0)" ::: "memory");
        }
    }
    __syncthreads();
}

constexpr int LDS_BAR_OFF = 160 * 1024 - 64;
static_assert(NAT_LDS_END <= LDS_BAR_OFF, "NAT LDS tiles overlap the barrier words");
__global__ void __launch_bounds__(512) fwd_megakernel(Params p) {
    extern __shared__ __attribute__((aligned(16))) unsigned char lds_raw[];
    LAS unsigned char* lds = (LAS unsigned char*)lds_raw;
    cg::grid_group grid = cg::this_grid();
    unsigned char* ws = p.ws;
#define W_XB ((bf16_t*)(ws + OFF_XB))
#define W_PB ((bf16_t*)(ws + OFF_P))
#define W_KAT ((bf16_t*)(ws + OFF_KAT))
#define W_VAT ((bf16_t*)(ws + OFF_VAT))
#define W_VBT ((bf16_t*)(ws + OFF_VBT))
#define W_LR ((float*)(ws + OFF_LR))
#define W_MIX ((bf16_t*)(ws + OFF_MIX))
#define W_Y1 ((float*)(ws + OFF_Y1))
#define W_Y1B ((bf16_t*)(ws + OFF_Y1B))
#define W_HB ((bf16_t*)(ws + OFF_H))
#define W_ST1 ((float*)(ws + OFF_ST1))
#define W_ST2 ((float*)(ws + OFF_ST2))
#define CVB ((const float*)(ws + OFF_CV))
#define c1in (CVB)
#define c2in (CVB + 2 * NPROJ)
#define c1f1 (CVB + 4 * NPROJ)
#define c2f1 (CVB + 4 * NPROJ + 2 * NF1)
#define GSYNC() do { for (int _r = 0; _r < SYNC_REPS; ++_r) xcd_barrier(xbar); } while (0)
    {   volatile LAS unsigned* stw = (volatile LAS unsigned*)(lds + LDS_BAR_OFF);
        if (threadIdx.x < 4) stw[threadIdx.x] = 0u;
        __syncthreads(); }
    const XcdBarrier xbar = xcd_barrier_post((unsigned*)(ws + OFF_BAR), (volatile LAS unsigned*)(lds + LDS_BAR_OFF));
    pg8::StaticOrder S;

#ifndef NO_PRO
    prologue_weights(p, lds);
#endif
    for (int c = 0; c < NCHUNK; ++c) {
        float* OUT = p.out + (size_t)c * TC * DM;
        convert_x(p.xp, p.xs, (size_t)c * TC, W_XB);
        if (c > 0) final_ln(p.out + (size_t)(c - 1) * TC * DM, W_Y1B, W_ST2, p.ln2g + DM, p.ln2b + DM);
        if (c == 0) grid.sync(); else GSYNC();
        for (int l = 0; l < 2; ++l) {
#ifndef NO_G1
            {   EpiProj E; E.P = W_PB; E.KAT = W_KAT; E.VAT = W_VAT; E.VBT = W_VBT; E.LR = W_LR;
                E.st = l ? W_ST2 : nullptr; E.c1 = c1in + l * NPROJ; E.c2 = c2in + l * NPROJ;
                pg8::Gemm g; g.A = W_XB; g.Bt = (const bf16_t*)(ws + OFF_WIN) + (size_t)l * NPROJ * DM; g.M = TC; g.N = NPROJ; g.K = DM;
                S.init(TC, NPROJ, gridDim.x, blockIdx.x);
                for (int rr = 0; rr < GEMM_REPS; ++rr) pg8::gemm_phase(lds, g, S, E); }
#endif
            GSYNC();
#ifndef NO_MIX
            for (int rep = 0; rep < MIX_REPS; ++rep) {
            for (int rr = 0; rr < NAT_REPS; ++rr) nat_mfma(lds, W_PB, W_VBT, p.rpb + (size_t)l * 8 * 15 * 31, W_MIX);
            for (int rr = 0; rr < G1_REPS; ++rr) gla_g1(lds, W_KAT, W_VAT, W_LR, p.gw2 + (size_t)l * 2 * 16 * 256, p.gb + (size_t)l * 2 * 256, (bf16_t*)(ws + OFF_DS), (float*)(ws + OFF_DEC), (float*)(ws + OFF_BC));
            GSYNC();
            gla_g2(lds, (bf16_t*)(ws + OFF_DS), (const float*)(ws + OFF_DEC));
            GSYNC();
            for (int rr = 0; rr < G3_REPS; ++rr) gla_g3(lds, W_PB, W_VAT, (const bf16_t*)(ws + OFF_DS), (const float*)(ws + OFF_BC), p.gng + (size_t)l * 512, W_MIX);
            GSYNC();
            }
#endif
#ifndef NO_G2
            {   EpiOut E; E.xres = W_XB; E.xp = p.xp; E.xs = p.xs; E.grow0 = (size_t)c * TC; E.st2 = l ? W_ST2 : nullptr; E.g2 = p.ln2g; E.b2 = p.ln2b; E.Y1B = W_Y1B; E.st1 = W_ST1;
                pg8::Gemm g; g.A = W_MIX; g.Bt = (const bf16_t*)(ws + OFF_WOUT) + (size_t)l * DM * DM; g.M = TC; g.N = DM; g.K = DM;
                S.init(TC, DM, gridDim.x, blockIdx.x);
                pg8::gemm_phase(lds, g, S, E); }
            GSYNC();
#endif
#ifndef NO_G3
            {   EpiF1 E; E.st1 = W_ST1; E.c1 = c1f1 + l * NF1; E.c2 = c2f1 + l * NF1; E.H = W_HB;
                pg8::Gemm g; g.A = W_Y1B; g.Bt = (const bf16_t*)(ws + OFF_WF1) + (size_t)l * NF1 * DM; g.M = TC; g.N = NF1; g.K = DM;
                S.init(TC, NF1, gridDim.x, blockIdx.x);
                for (int rr = 0; rr < GEMM_REPS; ++rr) pg8::gemm_phase(lds, g, S, E); }
            GSYNC();
#endif
#ifndef NO_G4
            {   EpiF2 E; E.Y1B = W_Y1B; E.st1 = W_ST1; E.g1 = p.ln1g + l * DM; E.b1 = p.ln1b + l * DM; E.OUT = OUT; E.XB = l ? W_Y1B : W_XB; E.st2 = W_ST2;
                pg8::Gemm g; g.A = W_HB; g.Bt = (const bf16_t*)(ws + OFF_WF2) + (size_t)l * DM * KF2; g.M = TC; g.N = DM; g.K = KF2;
                S.init(TC, DM, gridDim.x, blockIdx.x);
                pg8::gemm_phase(lds, g, S, E); }
#endif
            GSYNC();
        }
    }
    final_ln(p.out + (size_t)(NCHUNK - 1) * TC * DM, W_Y1B, W_ST2, p.ln2g + DM, p.ln2b + DM);
}

extern "C" void kernel_launch(void* const* d_in, const int* in_sizes, int n_in, void* d_out, int out_size, void* d_ws, size_t ws_size, hipStream_t stream) {
    constexpr size_t kLds = 160 * 1024;
    static int grid_blocks = 0;
    if (!grid_blocks) {
        int dev = 0, cus = 0, per_cu = 0;
        (void)hipGetDevice(&dev);
        (void)hipDeviceGetAttribute(&cus, hipDeviceAttributeMultiprocessorCount, dev);
        (void)hipFuncSetAttribute((const void*)fwd_megakernel, hipFuncAttributeMaxDynamicSharedMemorySize, (int)kLds);
        (void)hipOccupancyMaxActiveBlocksPerMultiprocessor(&per_cu, (const void*)fwd_megakernel, 512, kLds);
        if (per_cu < 1) per_cu = 1;
        grid_blocks = cus;
        if (n_in != 14 || ws_size < WS_END) { fprintf(stderr, "kernel_launch: unexpected n_in %d or ws_size %zu < %zu\n", n_in, ws_size, (size_t)WS_END); grid_blocks = -1; }
    }
    if (grid_blocks < 0) return;
    (void)hipMemsetAsync((unsigned char*)d_ws + OFF_CV, 0, al256(CV_BYTES) + BAR_BYTES, stream);
    Params p{};
    p.xp = (const float*)d_in[0]; p.xs = (const float*)d_in[1]; p.w_in = (const float*)d_in[2]; p.gw2 = (const float*)d_in[3]; p.gb = (const float*)d_in[4];
    p.gng = (const float*)d_in[5]; p.rpb = (const float*)d_in[6]; p.w_out = (const float*)d_in[7]; p.ln1g = (const float*)d_in[8]; p.ln1b = (const float*)d_in[9];
    p.wf1 = (const float*)d_in[10]; p.wf2 = (const float*)d_in[11]; p.ln2g = (const float*)d_in[12]; p.ln2b = (const float*)d_in[13];
    p.out = (float*)d_out; p.ws = (unsigned char*)d_ws;
    void* args[] = {&p};
    hipError_t e = hipLaunchCooperativeKernel((void*)fwd_megakernel, dim3(grid_blocks), dim3(512), args, kLds, stream);
    if (e != hipSuccess) fprintf(stderr, "cooperative launch failed: %s (grid %d)\n", hipGetErrorString(e), grid_blocks);
}
```

```cpp
#include <hip/hip_runtime.h>
#include <hip/hip_cooperative_groups.h>
#include <cstdio>
#ifndef NAT_REPS
#define NAT_REPS 1
#endif
#ifndef G1_REPS
#define G1_REPS 1
#endif
#ifndef G3_REPS
#define G3_REPS 1
#endif
#ifndef GEMM_REPS
#define GEMM_REPS 1
#endif
#ifndef MIX_REPS
#define MIX_REPS 1
#endif
#ifndef SYNC_REPS
#define SYNC_REPS 1
#endif
#ifndef NAIVE_NAT
#define NAIVE_NAT 0
#endif
#ifndef NAIVE_GLA
#define NAIVE_GLA 0
#endif
namespace cg = cooperative_groups;

#define LAS __attribute__((address_space(3)))
typedef unsigned short bf16_t;
typedef short bf16x8 __attribute__((ext_vector_type(8)));
typedef float f32x4 __attribute__((ext_vector_type(4)));
typedef unsigned u32x4 __attribute__((ext_vector_type(4)));
typedef unsigned u32x2 __attribute__((ext_vector_type(2)));

constexpr int DM = 1024, SEQ = 2048, CHB = 24, TC = CHB * SEQ, NCHUNK = 2, NPROMPT_ROWS = 32 * SEQ;
constexpr int NPROJ = 3328, NF1 = 5632, KF2 = 2816;
constexpr float ALPHA = 1.41421356237309515f, LN_EPS = 1e-5f;

constexpr size_t al256(size_t x) { return (x + 255) & ~(size_t)255; }
constexpr size_t OFF_WIN = 0;
constexpr size_t OFF_WOUT = OFF_WIN + al256(2ull * NPROJ * DM * 2);
constexpr size_t OFF_WF1 = OFF_WOUT + al256(2ull * DM * DM * 2);
constexpr size_t OFF_WF2 = OFF_WF1 + al256(2ull * NF1 * DM * 2);
constexpr size_t OFF_CV = OFF_WF2 + al256(2ull * DM * KF2 * 2);
constexpr size_t CV_BYTES = (2ull * NPROJ * 2 + 2ull * NF1 * 2) * 4;
constexpr size_t OFF_BAR = OFF_CV + al256(CV_BYTES);
constexpr size_t BAR_BYTES = 3456 * 4;
constexpr size_t OFF_XB = OFF_BAR + al256(BAR_BYTES);
constexpr size_t OFF_P = OFF_XB + al256((size_t)TC * 1024 * 2);
constexpr size_t OFF_KAT = OFF_P + al256((size_t)TC * 2048 * 2);
constexpr size_t OFF_VAT = OFF_KAT + al256((size_t)TC * 256 * 2);
constexpr size_t OFF_VBT = OFF_VAT + al256((size_t)TC * 512 * 2);
constexpr size_t OFF_LR = OFF_VBT + al256((size_t)TC * 512 * 2);
constexpr size_t OFF_MIX = OFF_LR + al256((size_t)TC * 32 * 4);
constexpr size_t OFF_Y1 = OFF_MIX + al256((size_t)TC * 1024 * 2);
constexpr size_t OFF_Y1B = OFF_Y1 + al256((size_t)TC * 1024 * 4);
constexpr size_t OFF_ST1 = OFF_Y1B + al256((size_t)TC * 1024 * 2);
constexpr size_t OFF_ST2 = OFF_ST1 + al256((size_t)TC * 32 * 4);
constexpr size_t OFF_DEC = OFF_ST2 + al256((size_t)TC * 32 * 4);
constexpr size_t WS_END = OFF_DEC + al256((size_t)CHB * 4 * 32 * 2 * 64 * 4);
constexpr size_t OFF_H = OFF_P;
constexpr size_t OFF_BC = OFF_Y1;
constexpr size_t OFF_DS = OFF_Y1B;
static_assert((size_t)TC * KF2 * 2 <= OFF_LR - OFF_P, "H does not fit its alias");
static_assert((size_t)CHB * 4 * 32 * 2 * 8192 * 2 <= (size_t)TC * 1024 * 2, "DS does not fit its alias");

struct Params {
    const float *xp, *xs, *w_in, *gw2, *gb, *gng, *rpb, *w_out, *ln1g, *ln1b, *wf1, *wf2, *ln2g, *ln2b;
    float* out; unsigned char* ws;
};

typedef __bf16 bf16x2_t __attribute__((ext_vector_type(2)));
typedef float f32x2_t __attribute__((ext_vector_type(2)));
__device__ __forceinline__ unsigned cvt_pk_bf16(float lo, float hi) { const f32x2_t f = {lo, hi}; const bf16x2_t v = __builtin_convertvector(f, bf16x2_t); return __builtin_bit_cast(unsigned, v); }
__device__ __forceinline__ bf16_t f2bf(float x) { return (bf16_t)(cvt_pk_bf16(x, 0.f) & 0xffffu); }
__device__ __forceinline__ float bf2f(bf16_t h) { return __uint_as_float(((unsigned)h) << 16); }
__device__ __forceinline__ float lo_bf(unsigned x) { return __uint_as_float(x << 16); }
__device__ __forceinline__ float hi_bf(unsigned x) { return __uint_as_float(x & 0xffff0000u); }
__device__ __forceinline__ float silu_f(float x) { return x * __builtin_amdgcn_rcpf(1.0f + __expf(-x)); }
__device__ __forceinline__ void row_stats(const float* st, int row, int fq, float& mu, float& rs) {
    const f32x4 a = *(const f32x4*)(st + (size_t)row * 32 + fq * 8), b = *(const f32x4*)(st + (size_t)row * 32 + fq * 8 + 4);
    float s = (a[0] + a[2]) + (b[0] + b[2]), q = (a[1] + a[3]) + (b[1] + b[3]);
    s += __shfl_xor(s, 16); s += __shfl_xor(s, 32); q += __shfl_xor(q, 16); q += __shfl_xor(q, 32);
    mu = s * (1.0f / 1024.0f); const float var = fmaxf(q * (1.0f / 1024.0f) - mu * mu, 0.f); rs = rsqrtf(var + LN_EPS);
}

__device__ __forceinline__ int opaque_tid() { int t = threadIdx.x; asm volatile("" : "+v"(t)); return t; }
__device__ __forceinline__ const float* xrow_ptr(const float* xp, const float* xs, size_t grow) {
    return grow < (size_t)NPROMPT_ROWS ? xp + grow * DM : xs + (grow - NPROMPT_ROWS) * DM;
}
namespace pg8 {
constexpr int BM = 256, BK = 64, HALF = 128, HTB = HALF * BK * 2, STAGE_BYTES = 8 * HTB, NXCD = 8, WGM = 8;
__host__ __device__ __forceinline__ int lds_byte(int r, int c) { const int st = (r >> 4) * 2 + (c >> 5), rr = r & 15, cc = c & 31, ob = rr * 64 + cc * 2; return st * 1024 + (ob ^ (((ob >> 9) & 1) << 5)); }
__host__ __device__ __forceinline__ void stage_rc(int b, int& R, int& C) { const int st = b / 1024, sb = b % 1024, swz = sb ^ (((sb >> 9) & 1) << 5); R = (st >> 1) * 16 + swz / 64; C = (st & 1) * 32 + (swz % 64) / 2; }
__host__ __device__ __forceinline__ int perm32(int rho) { const int n = rho >> 4, i = rho & 15; return 8 * (i >> 2) + 4 * n + (i & 3); }
struct Unit { int pm, pn; };
struct Gemm { const bf16_t* A; const bf16_t* Bt; int M, N, K; };
struct StaticOrder {
    int nM, nN, nwg, G, c;
    __host__ __device__ void init(int M, int N, int G_, int c_) { nM = M / BM; nN = N / BM; nwg = nM * nN; G = G_; c = c_; }
    __host__ __device__ bool next(int i, Unit& u) const {
        const long L = (long)i * G + c; if (L >= nwg) return false;
        int wgid = (int)L; { const int q = nwg / NXCD, r = nwg % NXCD, xcd = wgid % NXCD, off = wgid / NXCD; wgid = (xcd < r ? xcd * (q + 1) : r * (q + 1) + (xcd - r) * q) + off; }
        const int nig = WGM * nN, gid = wgid / nig, fm = gid * WGM, gsz = (nM - fm) < WGM ? (nM - fm) : WGM;
        u.pm = fm + ((wgid % nig) % gsz); u.pn = (wgid % nig) / gsz; return true;
    }
};
template <class Epi>
__device__ __forceinline__ void gemm_phase(LAS unsigned char* lds, const Gemm g, const StaticOrder& S, const Epi& E) {
    const int tid = opaque_tid(), wid = __builtin_amdgcn_readfirstlane(tid >> 6), lane = tid & 63, wr = wid >> 2, wc = wid & 3, fr = lane & 15, fq = lane >> 4;
    const int K = g.K, nt = K / BK;
    unsigned voffA[2], voffB[2];
#pragma unroll
    for (int i = 0; i < 2; ++i) { int R, C; stage_rc(tid * 16 + i * 8192, R, C); const int Rb = Epi::PERM ? ((R & ~31) + perm32(R & 31)) : R;
        voffA[i] = (unsigned)(R * K + C) * 2u; voffB[i] = (unsigned)(Rb * K + C) * 2u; }
    const size_t kstep = (size_t)(BK * 2);
    const size_t hstep = (size_t)HALF * K * 2;
    const size_t tstep = 2 * hstep;
    const unsigned ldsw = (unsigned)wid * 1024u;
    const int aoff = lds_byte(wr * 64 + fr, fq * 8), boff = lds_byte(wc * 32 + fr, fq * 8);
#define PG8_SA(b, h) (((b) * 2 + (h)) * HTB)
#define PG8_SB(b, h) ((4 + (b) * 2 + (h)) * HTB)
#define PG8_STAGE(bufoff, gbase, voff) do { _Pragma("unroll") for (int _i = 0; _i < 2; ++_i) \
        __builtin_amdgcn_global_load_lds((const unsigned*)((const char*)(gbase) + (voff)[_i]), (LAS unsigned*)(lds + (bufoff) + ldsw + _i * 8192), 16, 0, 0); } while (0)
#define PG8_LDA(dst, b, h) do { _Pragma("unroll") for (int m = 0; m < 4; ++m) _Pragma("unroll") for (int k = 0; k < 2; ++k) dst[m][k] = *(const LAS bf16x8*)(lds + PG8_SA(b, h) + aoff + m * 2048 + k * 1024); } while (0)
#define PG8_LDB(dst, b, h) do { _Pragma("unroll") for (int n = 0; n < 2; ++n) _Pragma("unroll") for (int k = 0; k < 2; ++k) dst[n][k] = *(const LAS bf16x8*)(lds + PG8_SB(b, h) + boff + n * 2048 + k * 1024); } while (0)
#define PG8_MMA(ai, bj, At, Bt) do { __builtin_amdgcn_s_setprio(1); _Pragma("unroll") for (int m = 0; m < 4; ++m) _Pragma("unroll") for (int n = 0; n < 2; ++n) _Pragma("unroll") for (int k = 0; k < 2; ++k) \
        acc[ai][bj][m][n] = __builtin_amdgcn_mfma_f32_16x16x32_bf16(Bt[n][k], At[m][k], acc[ai][bj][m][n], 0, 0, 0); __builtin_amdgcn_s_setprio(0); } while (0)
#define PG8_WAIT_V(n) asm volatile("s_waitcnt vmcnt(" #n ")" ::: "memory")
#define PG8_WAIT_L(n) asm volatile("s_waitcnt lgkmcnt(" #n ")" ::: "memory")
#define PG8_BAR __builtin_amdgcn_s_barrier()
#define PG8_SCHED __builtin_amdgcn_sched_barrier(0)
    Unit cur, nxt; int ui = 0;
    if (!S.next(0, cur)) return;
    f32x4 acc[2][2][4][2];
#pragma unroll
    for (int a = 0; a < 2; ++a)
#pragma unroll
        for (int b = 0; b < 2; ++b)
#pragma unroll
            for (int m = 0; m < 4; ++m)
#pragma unroll
                for (int n = 0; n < 2; ++n) acc[a][b][m][n] = (f32x4){0.f, 0.f, 0.f, 0.f};
    bf16x8 At[4][2], B0[2][2], B1[2][2];
    const char* cA = (const char*)g.A + (size_t)cur.pm * tstep; const char* cB = (const char*)g.Bt + (size_t)cur.pn * tstep;
    PG8_STAGE(PG8_SB(0, 0), cB, voffB); PG8_STAGE(PG8_SA(0, 0), cA, voffA); PG8_STAGE(PG8_SB(0, 1), cB + hstep, voffB); PG8_STAGE(PG8_SA(0, 1), cA + hstep, voffA);
    if (wr == 1) PG8_BAR;
    PG8_WAIT_V(4); PG8_BAR;
    PG8_STAGE(PG8_SB(1, 0), cB + kstep, voffB); PG8_STAGE(PG8_SA(1, 0), cA + kstep, voffA); PG8_STAGE(PG8_SB(1, 1), cB + hstep + kstep, voffB);
    PG8_WAIT_V(6); PG8_BAR;
    for (;;) {
        const bool has_next = S.next(ui + 1, nxt);
        const char* nA = has_next ? (const char*)g.A + (size_t)nxt.pm * tstep : cA; const char* nB = has_next ? (const char*)g.Bt + (size_t)nxt.pn * tstep : cB;
        for (int t = 0; t < nt; t += 2) {
            const bool last = (t == nt - 2);
            const char* a1 = cA + (size_t)(t + 1) * kstep;
            const char* a2 = last ? nA : cA + (size_t)(t + 2) * kstep; const char* b2 = last ? nB : cB + (size_t)(t + 2) * kstep;
            const char* a3 = a2 + kstep; const char* b3 = b2 + kstep;
            PG8_LDB(B0, 0, 0); PG8_SCHED; PG8_LDA(At, 0, 0); PG8_STAGE(PG8_SA(1, 1), a1 + hstep, voffA);
            PG8_WAIT_L(8); PG8_BAR; PG8_WAIT_L(0); PG8_MMA(0, 0, At, B0); PG8_BAR; PG8_SCHED;
            PG8_LDB(B1, 0, 1); PG8_STAGE(PG8_SB(0, 0), b2, voffB);
            PG8_BAR; PG8_WAIT_L(0); PG8_MMA(0, 1, At, B1); PG8_BAR;
            PG8_LDA(At, 0, 1); PG8_STAGE(PG8_SA(0, 0), a2, voffA);
            PG8_BAR; PG8_WAIT_L(0); PG8_MMA(1, 0, At, B0); PG8_BAR; PG8_SCHED;
            PG8_STAGE(PG8_SB(0, 1), b2 + hstep, voffB);
            PG8_WAIT_V(6); PG8_BAR; PG8_MMA(1, 1, At, B1); PG8_BAR;
            PG8_LDB(B0, 1, 0); PG8_SCHED; PG8_LDA(At, 1, 0); PG8_STAGE(PG8_SA(0, 1), a2 + hstep, voffA);
            PG8_WAIT_L(8); PG8_BAR; PG8_WAIT_L(0); PG8_MMA(0, 0, At, B0); PG8_BAR; PG8_SCHED;
            PG8_LDB(B1, 1, 1); PG8_STAGE(PG8_SB(1, 0), b3, voffB);
            PG8_BAR; PG8_WAIT_L(0); PG8_MMA(0, 1, At, B1); PG8_BAR;
            PG8_LDA(At, 1, 1); PG8_STAGE(PG8_SA(1, 0), a3, voffA);
            PG8_BAR; PG8_WAIT_L(0); PG8_MMA(1, 0, At, B0); PG8_BAR; PG8_SCHED;
            PG8_STAGE(PG8_SB(1, 1), b3 + hstep, voffB);
            PG8_WAIT_V(6); PG8_BAR; PG8_MMA(1, 1, At, B1); PG8_BAR;
        }
        E(acc, cur, wr, wc, fr, fq);
        if (!has_next) break;
#pragma unroll
        for (int a = 0; a < 2; ++a)
#pragma unroll
            for (int b = 0; b < 2; ++b)
#pragma unroll
                for (int m = 0; m < 4; ++m)
#pragma unroll
                    for (int n = 0; n < 2; ++n) acc[a][b][m][n] = (f32x4){0.f, 0.f, 0.f, 0.f};
        cur = nxt; cA = nA; cB = nB; ++ui;
    }
    PG8_WAIT_V(0);
    if (wr == 0) PG8_BAR;
    PG8_BAR;
#undef PG8_SA
#undef PG8_SB
#undef PG8_STAGE
#undef PG8_LDA
#undef PG8_LDB
#undef PG8_MMA
#undef PG8_WAIT_V
#undef PG8_WAIT_L
#undef PG8_BAR
#undef PG8_SCHED
}
}
using pg8::Unit;

__device__ __forceinline__ u32x4 pack8(const f32x4 a, const f32x4 b) { u32x4 w; w.x = cvt_pk_bf16(a[0], a[1]); w.y = cvt_pk_bf16(a[2], a[3]); w.z = cvt_pk_bf16(b[0], b[1]); w.w = cvt_pk_bf16(b[2], b[3]); return w; }
__device__ __forceinline__ void store_T8(bf16_t* p, const f32x4 a, const f32x4 b, const int odd) {
    bf16_t* q = odd ? p + 4 * (size_t)SEQ - 1 : p;
#pragma unroll
    for (int j = 0; j < 4; ++j) {
        const float pa = __shfl_xor(a[j], 1), pb = __shfl_xor(b[j], 1);
        *(unsigned*)(q + (size_t)j * SEQ) = odd ? cvt_pk_bf16(pb, b[j]) : cvt_pk_bf16(a[j], pa);
    }
}

struct EpiProj {
    static constexpr bool PERM = true;
    bf16_t *P, *KAT, *VAT, *VBT; float* LR;
    const float *st, *c1, *c2;
    __device__ __forceinline__ void operator()(const f32x4 (&acc)[2][2][4][2], const Unit& u, int wr, int wc, int fr_, int fq_) const {
        int fr = fr_, fq = fq_; asm volatile("" : "+v"(fr), "+v"(fq));
        const int pn = u.pn, lc = wc * 32 + fq * 8, bl = u.pm >> 3, tok0 = (u.pm & 7) * 256;
        f32x4 c1v[2][2], c2v[2][2];
#pragma unroll
        for (int bj = 0; bj < 2; ++bj)
#pragma unroll
            for (int n = 0; n < 2; ++n) {
                if (st) { c1v[bj][n] = *(const f32x4*)(c1 + pn * 256 + bj * 128 + lc + 4 * n); c2v[bj][n] = *(const f32x4*)(c2 + pn * 256 + bj * 128 + lc + 4 * n); }
                else { c1v[bj][n] = (f32x4){0.f, 0.f, 0.f, 0.f}; c2v[bj][n] = (f32x4){0.f, 0.f, 0.f, 0.f}; } }
        const bool isT = (pn == 1) || (pn == 2) || (pn == 3) || (pn == 10) || (pn == 11);
        const bool isP = !(pn == 2 || pn == 3 || pn >= 10);
        const int pcol0 = (pn < 2 ? pn : pn - 2) * 256;
        bf16_t* tb[2];
#pragma unroll
        for (int bj = 0; bj < 2; ++bj) { const int col = bj * 128 + lc;
            if (pn == 1) tb[bj] = KAT + ((size_t)(bl * 4 + (col >> 6)) * 64 + (col & 63)) * SEQ;
            else if (pn < 4) { const int cv = (pn - 2) * 256 + col; tb[bj] = VAT + ((size_t)(bl * 4 + (cv >> 7)) * 128 + (cv & 127)) * SEQ; }
            else { const int cv = (pn - 10) * 256 + col; tb[bj] = VBT + ((size_t)(bl * 8 + (cv >> 6)) * 64 + (cv & 63)) * SEQ; } }
#pragma unroll
        for (int ai = 0; ai < 2; ++ai)
#pragma unroll
            for (int m = 0; m < 4; ++m) {
                const int rt = ai * 128 + m * 16 + wr * 64 + fr, grow = u.pm * 256 + rt, tok = tok0 + rt;
                float mu = 0.f, rs = 1.f; if (st) row_stats(st, grow, fq, mu, rs);
#pragma unroll
                for (int bj = 0; bj < 2; ++bj) {
                    const f32x4 v0 = (acc[ai][bj][m][0] - mu * c1v[bj][0]) * rs + c2v[bj][0];
                    const f32x4 v1 = (acc[ai][bj][m][1] - mu * c1v[bj][1]) * rs + c2v[bj][1];
                    const int col = bj * 128 + lc;
                    if (pn == 12) { if (col < 32) { *(f32x4*)(LR + (size_t)grow * 32 + col) = v0; *(f32x4*)(LR + (size_t)grow * 32 + col + 4) = v1; } }
                    else {
                        if (isP) *(u32x4*)(P + (size_t)grow * 2048 + pcol0 + col) = pack8(v0, v1);
                        if (isT) store_T8(tb[bj] + tok, v0, v1, fr & 1);
                    }
                }
            }
    }
};

struct EpiOut {
    static constexpr bool PERM = true;
    const bf16_t* xres; const float *xp, *xs; size_t grow0; const float *st2, *g2, *b2;
    bf16_t* Y1B; float* st1;
    __device__ __forceinline__ void operator()(const f32x4 (&acc)[2][2][4][2], const Unit& u, int wr, int wc, int fr_, int fq_) const {
        int fr = fr_, fq = fq_; asm volatile("" : "+v"(fr), "+v"(fq));
        const int lc = wc * 32 + fq * 8;
        const float* xb = xrow_ptr(xp, xs, grow0 + (size_t)u.pm * 256) - (size_t)u.pm * 256 * 1024;
        f32x4 gv[2][2], bv[2][2];
#pragma unroll
        for (int bj = 0; bj < 2; ++bj)
#pragma unroll
            for (int n = 0; n < 2; ++n) { const int col = u.pn * 256 + bj * 128 + lc + 4 * n;
                if (st2) { gv[bj][n] = *(const f32x4*)(g2 + col); bv[bj][n] = *(const f32x4*)(b2 + col); } else { gv[bj][n] = (f32x4){1.f, 1.f, 1.f, 1.f}; bv[bj][n] = (f32x4){0.f, 0.f, 0.f, 0.f}; } }
#pragma unroll
        for (int am = 0; am < 4; ++am) { const int ai = am >> 1, m0 = (am & 1) * 2;
            f32x4 xr[2][2][2]; float mu[2], rs[2];
#pragma unroll
            for (int mm = 0; mm < 2; ++mm) { const int m = mm; const int mg = m0 + mm;
                const int grow = u.pm * 256 + ai * 128 + mg * 16 + wr * 64 + fr;
#pragma unroll
                for (int bj = 0; bj < 2; ++bj) { const size_t off = (size_t)grow * 1024 + u.pn * 256 + bj * 128 + lc;
                    if (st2) { const u32x4 w = *(const u32x4*)(xres + off);
                        xr[m][bj][0] = (f32x4){lo_bf(w.x), hi_bf(w.x), lo_bf(w.y), hi_bf(w.y)}; xr[m][bj][1] = (f32x4){lo_bf(w.z), hi_bf(w.z), lo_bf(w.w), hi_bf(w.w)}; }
                    else { xr[m][bj][0] = *(const f32x4*)(xb + off); xr[m][bj][1] = *(const f32x4*)(xb + off + 4); } }
                mu[m] = 0.f; rs[m] = 1.f; if (st2) row_stats(st2, grow, fq, mu[m], rs[m]);
            }
            asm volatile("" ::: "memory");
#pragma unroll
            for (int mm = 0; mm < 2; ++mm) { const int m = mm; const int mg = m0 + mm;
                const int grow = u.pm * 256 + ai * 128 + mg * 16 + wr * 64 + fr;
                float s = 0.f, ss = 0.f;
#pragma unroll
                for (int bj = 0; bj < 2; ++bj) { const size_t off = (size_t)grow * 1024 + u.pn * 256 + bj * 128 + lc;
                    const f32x4 x0 = (xr[m][bj][0] - mu[m]) * rs[m] * gv[bj][0] + bv[bj][0], x1 = (xr[m][bj][1] - mu[m]) * rs[m] * gv[bj][1] + bv[bj][1];
                    const f32x4 y0 = x0 * ALPHA + acc[ai][bj][mg][0], y1 = x1 * ALPHA + acc[ai][bj][mg][1];
                    *(u32x4*)(Y1B + off) = pack8(y0, y1);
                    s += (y0[0] + y0[1]) + (y0[2] + y0[3]) + (y1[0] + y1[1]) + (y1[2] + y1[3]);
                    ss += (y0[0] * y0[0] + y0[1] * y0[1]) + (y0[2] * y0[2] + y0[3] * y0[3]) + (y1[0] * y1[0] + y1[1] * y1[1]) + (y1[2] * y1[2] + y1[3] * y1[3]);
                }
                s += __shfl_xor(s, 16); s += __shfl_xor(s, 32); ss += __shfl_xor(ss, 16); ss += __shfl_xor(ss, 32);
                if (fq == 0) { f32x2_t o2 = {s, ss}; *(f32x2_t*)(st1 + (size_t)grow * 32 + (u.pn * 4 + wc) * 2) = o2; }
            }
        }
    }
};

struct EpiF1 {
    static constexpr bool PERM = true;
    const float *st1, *c1, *c2; bf16_t* H;
    __device__ __forceinline__ void operator()(const f32x4 (&acc)[2][2][4][2], const Unit& u, int wr, int wc, int fr_, int fq_) const {
        int fr = fr_, fq = fq_; asm volatile("" : "+v"(fr), "+v"(fq));
        const int lc = wc * 32 + fq * 8;
        f32x4 c1v[2][2], c2v[2][2];
#pragma unroll
        for (int bj = 0; bj < 2; ++bj)
#pragma unroll
            for (int n = 0; n < 2; ++n) { c1v[bj][n] = *(const f32x4*)(c1 + u.pn * 256 + bj * 128 + lc + 4 * n); c2v[bj][n] = *(const f32x4*)(c2 + u.pn * 256 + bj * 128 + lc + 4 * n); }
#pragma unroll
        for (int ai = 0; ai < 2; ++ai)
#pragma unroll
            for (int m = 0; m < 4; ++m) {
                const int grow = u.pm * 256 + ai * 128 + m * 16 + wr * 64 + fr;
                float mu, rs; row_stats(st1, grow, fq, mu, rs);
                f32x4 h[2];
#pragma unroll
                for (int n = 0; n < 2; ++n) {
                    const f32x4 g = (acc[ai][0][m][n] - mu * c1v[0][n]) * rs + c2v[0][n];
                    const f32x4 up = (acc[ai][1][m][n] - mu * c1v[1][n]) * rs + c2v[1][n];
#pragma unroll
                    for (int j = 0; j < 4; ++j) h[n][j] = silu_f(g[j]) * up[j];
                }
                *(u32x4*)(H + (size_t)grow * KF2 + u.pn * 128 + lc) = pack8(h[0], h[1]);
            }
    }
};

struct EpiF2 {
    static constexpr bool PERM = true;
    const bf16_t* Y1B; const float *st1, *g1, *b1; float* OUT; bf16_t* XB; float* st2;
    __device__ __forceinline__ void operator()(const f32x4 (&acc)[2][2][4][2], const Unit& u, int wr, int wc, int fr_, int fq_) const {
        int fr = fr_, fq = fq_; asm volatile("" : "+v"(fr), "+v"(fq));
        const int lc = wc * 32 + fq * 8;
        f32x4 gv[2][2], bv[2][2];
#pragma unroll
        for (int bj = 0; bj < 2; ++bj)
#pragma unroll
            for (int n = 0; n < 2; ++n) { const int col = u.pn * 256 + bj * 128 + lc + 4 * n; gv[bj][n] = *(const f32x4*)(g1 + col); bv[bj][n] = *(const f32x4*)(b1 + col); }
#pragma unroll
        for (int am = 0; am < 4; ++am) { const int ai = am >> 1, m0 = (am & 1) * 2;
            u32x4 w[2][2]; float mu[2], rs[2];
#pragma unroll
            for (int mm = 0; mm < 2; ++mm) { const int m = mm; const int mg = m0 + mm;
                const int grow = u.pm * 256 + ai * 128 + mg * 16 + wr * 64 + fr;
#pragma unroll
                for (int bj = 0; bj < 2; ++bj) w[m][bj] = *(const u32x4*)(Y1B + (size_t)grow * 1024 + u.pn * 256 + bj * 128 + lc);
                row_stats(st1, grow, fq, mu[m], rs[m]);
            }
            asm volatile("" ::: "memory");
#pragma unroll
            for (int mm = 0; mm < 2; ++mm) { const int m = mm; const int mg = m0 + mm;
                const int grow = u.pm * 256 + ai * 128 + mg * 16 + wr * 64 + fr;
                float s = 0.f, ss = 0.f;
#pragma unroll
                for (int bj = 0; bj < 2; ++bj) { const size_t off = (size_t)grow * 1024 + u.pn * 256 + bj * 128 + lc; const u32x4 ww = w[m][bj];
                    f32x4 x0 = (f32x4){lo_bf(ww.x), hi_bf(ww.x), lo_bf(ww.y), hi_bf(ww.y)}, x1 = (f32x4){lo_bf(ww.z), hi_bf(ww.z), lo_bf(ww.w), hi_bf(ww.w)};
                    x0 = (x0 - mu[m]) * rs[m] * gv[bj][0] + bv[bj][0]; x1 = (x1 - mu[m]) * rs[m] * gv[bj][1] + bv[bj][1];
                    const f32x4 y0 = x0 * ALPHA + acc[ai][bj][mg][0], y1 = x1 * ALPHA + acc[ai][bj][mg][1];
                    *(u32x4*)(XB + off) = pack8(y0, y1);
                    s += (y0[0] + y0[1]) + (y0[2] + y0[3]) + (y1[0] + y1[1]) + (y1[2] + y1[3]);
                    ss += (y0[0] * y0[0] + y0[1] * y0[1]) + (y0[2] * y0[2] + y0[3] * y0[3]) + (y1[0] * y1[0] + y1[1] * y1[1]) + (y1[2] * y1[2] + y1[3] * y1[3]);
                }
                s += __shfl_xor(s, 16); s += __shfl_xor(s, 32); ss += __shfl_xor(ss, 16); ss += __shfl_xor(ss, 32);
                if (fq == 0) { f32x2_t o2 = {s, ss}; *(f32x2_t*)(st2 + (size_t)grow * 32 + (u.pn * 4 + wc) * 2) = o2; }
            }
        }
    }
};

struct MapIn { __device__ static int src(int n) { return n < 1536 ? n : (n < 3072 ? n + 32 : (n < 3104 ? n - 3072 + 1536 : -1)); }
               __device__ static float scale(int n) { return (n < 256 || (n >= 1536 && n < 2048)) ? 0.125f : 1.0f; } };
struct MapId { __device__ static int src(int n) { return n; } __device__ static float scale(int) { return 1.0f; } };
struct MapF1 { __device__ static int src(int n) { const int t = n >> 8, r = n & 255; return r < 128 ? t * 128 + r : 2816 + t * 128 + (r - 128); } __device__ static float scale(int) { return 1.0f; } };

template <class Map>
__device__ __forceinline__ void wt_unit(LAS float* lf, const float* W, int ldw, int K, bf16_t* Wt, int kt, int nt, const float* g, const float* b, float* c1, float* c2) {
    const int tid = opaque_tid();
    {   const int nl = tid & 63, n = nt * 64 + nl, src = Map::src(n); const float sc = Map::scale(n);
#pragma unroll
        for (int i = 0; i < 8; ++i) { const int kl = (tid >> 6) + 8 * i; lf[kl * 65 + nl] = src >= 0 ? W[(size_t)(kt * 64 + kl) * ldw + src] * sc : 0.f; } }
    __syncthreads();
    {   const int nl = tid >> 3, ks = (tid & 7) * 8, n = nt * 64 + nl; float v[8]; float s1 = 0.f, s2 = 0.f;
#pragma unroll
        for (int j = 0; j < 8; ++j) { const float w = lf[(ks + j) * 65 + nl]; const int k = kt * 64 + ks + j; const float gv = g ? g[k] : 1.0f; const float bv = b ? b[k] : 0.f;
            const float r = bf2f(f2bf(w * gv)); v[j] = r; s1 += r; s2 += w * bv; }
        u32x4 pk; pk.x = cvt_pk_bf16(v[0], v[1]); pk.y = cvt_pk_bf16(v[2], v[3]); pk.z = cvt_pk_bf16(v[4], v[5]); pk.w = cvt_pk_bf16(v[6], v[7]);
        *(u32x4*)(Wt + (size_t)n * K + kt * 64 + ks) = pk;
        if (c1) { s1 += __shfl_xor(s1, 1); s1 += __shfl_xor(s1, 2); s1 += __shfl_xor(s1, 4); s2 += __shfl_xor(s2, 1); s2 += __shfl_xor(s2, 2); s2 += __shfl_xor(s2, 4);
            if ((tid & 7) == 0) { atomicAdd(c1 + n, s1); atomicAdd(c2 + n, s2); } } }
    __syncthreads();
}

__device__ __forceinline__ void prologue_weights(const Params& p, LAS unsigned char* lds) {
    LAS float* lf = (LAS float*)lds;
    unsigned char* ws = p.ws;
    float* cv = (float*)(ws + OFF_CV);
    float *c1in = cv, *c2in = cv + 2 * NPROJ, *c1f1 = cv + 4 * NPROJ, *c2f1 = cv + 4 * NPROJ + 2 * NF1;
    for (int u = blockIdx.x; u < 6400; u += gridDim.x) {
        if (u < 1664) { const int l = u / 832, r = u % 832, kt = r / 52, nt = r % 52;
            wt_unit<MapIn>(lf, p.w_in + (size_t)l * DM * 3104, 3104, DM, (bf16_t*)(ws + OFF_WIN) + (size_t)l * NPROJ * DM, kt, nt,
                           l ? p.ln2g : nullptr, l ? p.ln2b : nullptr, l ? c1in + NPROJ : nullptr, l ? c2in + NPROJ : nullptr); }
        else if (u < 2176) { const int v = u - 1664, l = v / 256, r = v % 256, kt = r / 16, nt = r % 16;
            wt_unit<MapId>(lf, p.w_out + (size_t)l * DM * DM, DM, DM, (bf16_t*)(ws + OFF_WOUT) + (size_t)l * DM * DM, kt, nt, nullptr, nullptr, nullptr, nullptr); }
        else if (u < 4992) { const int v = u - 2176, l = v / 1408, r = v % 1408, kt = r / 88, nt = r % 88;
            wt_unit<MapF1>(lf, p.wf1 + (size_t)l * DM * NF1, NF1, DM, (bf16_t*)(ws + OFF_WF1) + (size_t)l * NF1 * DM, kt, nt,
                           p.ln1g + l * DM, p.ln1b + l * DM, c1f1 + l * NF1, c2f1 + l * NF1); }
        else { const int v = u - 4992, l = v / 704, r = v % 704, kt = r / 16, nt = r % 16;
            wt_unit<MapId>(lf, p.wf2 + (size_t)l * KF2 * DM, DM, KF2, (bf16_t*)(ws + OFF_WF2) + (size_t)l * DM * KF2, kt, nt, nullptr, nullptr, nullptr, nullptr); }
    }
}

__device__ __forceinline__ void convert_x(const float* xp, const float* xs, size_t grow0, bf16_t* XB) {
    const size_t n8 = (size_t)TC * DM / 8;
    for (size_t i = (size_t)blockIdx.x * 512 + opaque_tid(); i < n8; i += (size_t)gridDim.x * 512) {
        const float* x = xrow_ptr(xp, xs, grow0 + (i >> 7)) + (i & 127) * 8;
        const f32x4 a = *(const f32x4*)x, b = *(const f32x4*)(x + 4);
        *(u32x4*)(XB + i * 8) = pack8(a, b);
    }
}
__device__ __forceinline__ void final_ln(float* out, const bf16_t* y, const float* st2, const float* g, const float* b) {
    const int tid = opaque_tid(), lane = tid & 63, wv = tid >> 6;
    for (int row = blockIdx.x * 8 + wv; row < TC; row += gridDim.x * 8) {
        const f32x2_t pr = *(const f32x2_t*)(st2 + (size_t)row * 32 + (lane & 15) * 2);
        float s = pr[0], q = pr[1];
#pragma unroll
        for (int d = 1; d < 16; d <<= 1) { s += __shfl_xor(s, d); q += __shfl_xor(q, d); }
        const float mu = s * (1.0f / 1024.0f), rs = rsqrtf(fmaxf(q * (1.0f / 1024.0f) - mu * mu, 0.f) + LN_EPS);
#pragma unroll
        for (int k = 0; k < 2; ++k) { const int c8 = (k * 64 + lane) * 8; const u32x4 w = *(const u32x4*)(y + (size_t)row * 1024 + c8);
            const f32x4 x0 = (f32x4){lo_bf(w.x), hi_bf(w.x), lo_bf(w.y), hi_bf(w.y)}, x1 = (f32x4){lo_bf(w.z), hi_bf(w.z), lo_bf(w.w), hi_bf(w.w)};
            float* po = out + (size_t)row * 1024 + c8;
            *(f32x4*)po = (x0 - mu) * rs * *(const f32x4*)(g + c8) + *(const f32x4*)(b + c8);
            *(f32x4*)(po + 4) = (x1 - mu) * rs * *(const f32x4*)(g + c8 + 4) + *(const f32x4*)(b + c8 + 4); }
    }
}
__device__ __forceinline__ void zero_f32(float* p, size_t n) {
    for (size_t i = (size_t)blockIdx.x * 512 + opaque_tid(); i < n; i += (size_t)gridDim.x * 512) p[i] = 0.f;
}

__device__ __forceinline__ float log_sigmoid_f(float z) { return fminf(z, 0.f) - log1pf(expf(-fabsf(z))); }

typedef __attribute__((ext_vector_type(2))) float f32x2;
__device__ __forceinline__ f32x4 mfma16(bf16x8 a, bf16x8 b, f32x4 c) { return __builtin_amdgcn_mfma_f32_16x16x32_bf16(a, b, c, 0, 0, 0); }
__device__ __forceinline__ bf16x8 scale8(bf16x8 raw, f32x4 e0, f32x4 e1) {
    const u32x4 r = __builtin_bit_cast(u32x4, raw); u32x4 o;
    o.x = cvt_pk_bf16(lo_bf(r.x) * e0[0], hi_bf(r.x) * e0[1]); o.y = cvt_pk_bf16(lo_bf(r.y) * e0[2], hi_bf(r.y) * e0[3]);
    o.z = cvt_pk_bf16(lo_bf(r.z) * e1[0], hi_bf(r.z) * e1[1]); o.w = cvt_pk_bf16(lo_bf(r.w) * e1[2], hi_bf(r.w) * e1[3]);
    return __builtin_bit_cast(bf16x8, o);
}
constexpr int HALF_LDS = 45056;
constexpr int ROWP = 68;
#define MEMBAR() asm volatile("" ::: "memory")

__device__ __forceinline__ float log_sigmoid_fast(float z) {
    const float e = __builtin_amdgcn_exp2f(-1.44269504088896f * fabsf(z));
    return fminf(z, 0.f) - 0.693147180559945f * __builtin_amdgcn_logf(1.0f + e);
}
__device__ __forceinline__ void gla_gates(const LAS float* lrs, const float* w2, const float* gbias, int h, int d, int w, float (&pf)[16], float (&sb)[16]) {
    float wf[16], wb[16];
#pragma unroll
    for (int r = 0; r < 16; ++r) { wf[r] = w2[r * 256 + h * 64 + d]; wb[r] = w2[(16 + r) * 256 + h * 64 + d]; }
    const float bf = gbias[h * 64 + d], bb = gbias[256 + h * 64 + d];
#pragma unroll
    for (int j = 0; j < 16; ++j) {
        const LAS float* lr = lrs + (w * 16 + j) * 32;
        f32x2_t z2 = {bf, bb};
#pragma unroll
        for (int r4 = 0; r4 < 4; ++r4) { const f32x4 a = *(const LAS f32x4*)(lr + 4 * r4), b = *(const LAS f32x4*)(lr + 16 + 4 * r4);
#pragma unroll
            for (int q = 0; q < 4; ++q) { const f32x2_t x2 = {a[q], b[q]}, w2v = {wf[4 * r4 + q], wb[4 * r4 + q]}; z2 = __builtin_elementwise_fma(x2, w2v, z2); } }
        pf[j] = log_sigmoid_fast(z2[0]) * (1.0f / 16.0f); sb[j] = log_sigmoid_fast(z2[1]) * (1.0f / 16.0f);
    }
#pragma unroll
    for (int j = 1; j < 16; ++j) pf[j] += pf[j - 1];
#pragma unroll
    for (int j = 14; j >= 0; --j) sb[j] += sb[j + 1];
}

__device__ __forceinline__ void gla_g1(LAS unsigned char* lds, const bf16_t* KAT, const bf16_t* VAT, const float* LR, const float* w2, const float* gbias, bf16_t* DS, float* DEC, float* BC) {
    const int tid = opaque_tid(), half = tid >> 8, t256 = tid & 255, d = tid & 63, lane = tid & 63, fr = lane & 15, g = lane >> 4;
    const int w = __builtin_amdgcn_readfirstlane((tid >> 6) & 3);
    LAS float* tot = (LAS float*)(lds + half * HALF_LDS);
    LAS float* ETf = tot + 512; LAS float* ETb = ETf + 64 * ROWP; LAS float* LRS = ETb + 64 * ROWP;
    for (int it = blockIdx.x; it < CHB * 4 * 32 / 2; it += gridDim.x) {
        const int uid = it * 2 + half, c = uid & 31, h = (uid >> 5) & 3, bl = uid >> 7;
        const size_t row0 = (size_t)bl * SEQ + c * 64;
        const bf16_t* kat = KAT + ((size_t)(bl * 4 + h) * 64) * SEQ + c * 64;
        const bf16_t* vat = VAT + ((size_t)(bl * 4 + h) * 128) * SEQ + c * 64;
        const f32x4 l0 = *(const f32x4*)(LR + row0 * 32 + t256 * 8), l1 = *(const f32x4*)(LR + row0 * 32 + t256 * 8 + 4);
        bf16x8 bfr[2][2], kraw[2][4];
#pragma unroll
        for (int t = 0; t < 2; ++t) {
#pragma unroll
            for (int e = 0; e < 2; ++e) bfr[t][e] = *(const bf16x8*)(vat + (size_t)(16 * (2 * w + e) + fr) * SEQ + 32 * t + 8 * g);
#pragma unroll
            for (int mb = 0; mb < 4; ++mb) kraw[t][mb] = *(const bf16x8*)(kat + (size_t)(16 * mb + fr) * SEQ + 32 * t + 8 * g);
        }
        MEMBAR();
        *(LAS f32x4*)(LRS + t256 * 8) = l0; *(LAS f32x4*)(LRS + t256 * 8 + 4) = l1;
        __syncthreads();
        float pf[16], sb[16];
        gla_gates(LRS, w2, gbias, h, d, w, pf, sb);
        tot[w * 64 + d] = pf[15]; tot[(4 + w) * 64 + d] = sb[0];
        __syncthreads();
        float offf = 0.f, offb = 0.f, totf = 0.f, totb = 0.f;
#pragma unroll
        for (int q = 0; q < 4; ++q) { const float a = tot[q * 64 + d], b = tot[(4 + q) * 64 + d]; totf += a; totb += b; if (q < w) offf += a; if (q > w) offb += b; }
#pragma unroll
        for (int j4 = 0; j4 < 4; ++j4) { f32x4 vf, vb;
#pragma unroll
            for (int jj = 0; jj < 4; ++jj) { vf[jj] = __expf(totf - (offf + pf[j4 * 4 + jj])); vb[jj] = __expf(totb - (offb + sb[j4 * 4 + jj])); }
            *(LAS f32x4*)(ETf + d * ROWP + w * 16 + j4 * 4) = vf; *(LAS f32x4*)(ETb + d * ROWP + w * 16 + j4 * 4) = vb; }
        if (w == 0) { DEC[((size_t)uid * 2 + 0) * 64 + d] = __expf(totf); DEC[((size_t)uid * 2 + 1) * 64 + d] = __expf(totb); }
        {   float* bc = BC + (size_t)uid * 8192 + (w * 16) * 64 + d;
#pragma unroll
            for (int j = 0; j < 16; ++j) { bc[j * 64] = (offf + pf[j]) * 1.44269504088896f; bc[4096 + j * 64] = (offb + sb[j]) * 1.44269504088896f; } }
        __syncthreads();
        f32x4 acc[2][4][2];
#pragma unroll
        for (int a = 0; a < 2; ++a)
#pragma unroll
            for (int b = 0; b < 4; ++b)
#pragma unroll
                for (int e = 0; e < 2; ++e) acc[a][b][e] = (f32x4){0.f, 0.f, 0.f, 0.f};
#pragma unroll
        for (int t = 0; t < 2; ++t) {
#pragma unroll
            for (int mb = 0; mb < 4; ++mb) {
                const LAS float* ef = ETf + (16 * mb + fr) * ROWP + 32 * t + 8 * g; const LAS float* eb = ETb + (16 * mb + fr) * ROWP + 32 * t + 8 * g;
                const bf16x8 af = scale8(kraw[t][mb], *(const LAS f32x4*)ef, *(const LAS f32x4*)(ef + 4)), ab = scale8(kraw[t][mb], *(const LAS f32x4*)eb, *(const LAS f32x4*)(eb + 4));
#pragma unroll
                for (int e = 0; e < 2; ++e) { acc[0][mb][e] = mfma16(af, bfr[t][e], acc[0][mb][e]); acc[1][mb][e] = mfma16(ab, bfr[t][e], acc[1][mb][e]); }
            }
        }
#pragma unroll
        for (int dir = 0; dir < 2; ++dir)
#pragma unroll
            for (int mb = 0; mb < 4; ++mb)
#pragma unroll
                for (int e = 0; e < 2; ++e) { const f32x4 a = acc[dir][mb][e]; u32x2 o; o.x = cvt_pk_bf16(a[0], a[1]); o.y = cvt_pk_bf16(a[2], a[3]);
                    *(u32x2*)(DS + (((size_t)uid * 2 + dir) * 128 + 16 * (2 * w + e) + fr) * 64 + 16 * mb + 4 * g) = o; }
        __syncthreads();
    }
}

__device__ __forceinline__ void gla_g2(LAS unsigned char* lds, bf16_t* DS, const float* DEC) {
    const int tid = opaque_tid();
    LAS float* dl = (LAS float*)lds;
    for (int it = blockIdx.x; it < CHB * 4 * 2 * 2; it += gridDim.x) {
        const int e = (it & 1) * 512 + tid, bhd = it >> 1, dir = bhd & 1, bh = bhd >> 1;
        {   const int i4 = tid * 4, cc = i4 >> 6, dk = i4 & 63;
            *(LAS f32x4*)(dl + i4) = *(const f32x4*)(DEC + ((size_t)(bh * 32 + cc) * 2 + dir) * 64 + dk); }
        u32x4 dsv[32];
#pragma unroll
        for (int k = 0; k < 32; ++k) { const int c = dir ? 31 - k : k; dsv[k] = *(const u32x4*)(DS + ((size_t)(bh * 32 + c) * 2 + dir) * 8192 + (size_t)e * 8); }
        MEMBAR();
        __syncthreads();
        float S[8];
#pragma unroll
        for (int q = 0; q < 8; ++q) S[q] = 0.f;
#pragma unroll
        for (int k = 0; k < 32; ++k) { const int c = dir ? 31 - k : k;
            const f32x4 d0 = *(const LAS f32x4*)(dl + c * 64 + (e & 7) * 8), d1 = *(const LAS f32x4*)(dl + c * 64 + (e & 7) * 8 + 4);
            u32x4 o; o.x = cvt_pk_bf16(S[0], S[1]); o.y = cvt_pk_bf16(S[2], S[3]); o.z = cvt_pk_bf16(S[4], S[5]); o.w = cvt_pk_bf16(S[6], S[7]);
            *(u32x4*)(DS + ((size_t)(bh * 32 + c) * 2 + dir) * 8192 + (size_t)e * 8) = o;
            S[0] = d0[0] * S[0] + lo_bf(dsv[k].x); S[1] = d0[1] * S[1] + hi_bf(dsv[k].x); S[2] = d0[2] * S[2] + lo_bf(dsv[k].y); S[3] = d0[3] * S[3] + hi_bf(dsv[k].y);
            S[4] = d1[0] * S[4] + lo_bf(dsv[k].z); S[5] = d1[1] * S[5] + hi_bf(dsv[k].z); S[6] = d1[2] * S[6] + lo_bf(dsv[k].w); S[7] = d1[3] * S[7] + hi_bf(dsv[k].w); }
        __syncthreads();
    }
}

constexpr int G3_KRAW = 0, G3_VT = 9216, G3_SF = 27648, G3_SB = 46080, G3_TBF = 64512, G3_TBB = 81920, G3_KIF = 99328, G3_KIB = 108544, G3_RED = 117760;
__device__ __forceinline__ void g3_dma_tile(LAS unsigned char* dst, const unsigned char* src, int row_bytes_src, int D, int ninstr, int wv, int lane) {
    for (int q = wv; q < ninstr; q += 8) { const int C = 64 * q + lane, row = C / (D + 1), pos = min(C - row * (D + 1), D - 1);
        __builtin_amdgcn_global_load_lds((const unsigned*)(src + (size_t)row * row_bytes_src + pos * 16), (LAS unsigned*)(dst + q * 1024), 16, 0, 0); }
}
__device__ __forceinline__ void g3_dma_unit(LAS unsigned char* lds, const bf16_t* P, const bf16_t* VAT, const bf16_t* DS, const float* BC, int uid, int wv, int lane) {
    const int c = uid & 31, h = (uid >> 5) & 3, bl = uid >> 7;
    const size_t row0 = (size_t)bl * SEQ + c * 64;
    g3_dma_tile(lds + G3_KRAW, (const unsigned char*)(P + row0 * 2048 + 256 + h * 64), 4096, 8, 9, wv, lane);
    g3_dma_tile(lds + G3_VT, (const unsigned char*)(VAT + ((size_t)(bl * 4 + h) * 128) * SEQ + c * 64), SEQ * 2, 8, 18, wv, lane);
    g3_dma_tile(lds + G3_SF, (const unsigned char*)(DS + ((size_t)uid * 2 + 0) * 8192), 128, 8, 18, wv, lane);
    g3_dma_tile(lds + G3_SB, (const unsigned char*)(DS + ((size_t)uid * 2 + 1) * 8192), 128, 8, 18, wv, lane);
    g3_dma_tile(lds + G3_TBF, (const unsigned char*)(BC + (size_t)uid * 8192), 256, 16, 17, wv, lane);
    g3_dma_tile(lds + G3_TBB, (const unsigned char*)(BC + (size_t)uid * 8192 + 4096), 256, 16, 17, wv, lane);
}
__device__ __forceinline__ void gla_g3(LAS unsigned char* lds, const bf16_t* P, const bf16_t* VAT, const bf16_t* DS, const float* BC, const float* gn, bf16_t* MIX) {
    const int tid = opaque_tid(), lane = tid & 63, fr = lane & 15, g = lane >> 4;
    const int wv = __builtin_amdgcn_readfirstlane(tid >> 6), rb = wv & 3, dvh = wv >> 2;
    const int iq = 16 * rb + fr;
    const int nun = CHB * 4 * 32;
    int uid = blockIdx.x;
    if (uid < nun) g3_dma_unit(lds, P, VAT, DS, BC, uid, wv, lane);
    for (; uid < nun; uid += gridDim.x) {
        const int c = uid & 31, h = (uid >> 5) & 3, bl = uid >> 7;
        const size_t row0 = (size_t)bl * SEQ + c * 64, qrow = row0 + iq;
        bf16x8 qraw[2]; f32x4 gvv[4]; u32x2 rvv[4];
#pragma unroll
        for (int s2 = 0; s2 < 2; ++s2) qraw[s2] = *(const bf16x8*)(P + qrow * 2048 + h * 64 + 32 * s2 + 8 * g);
#pragma unroll
        for (int mb = 0; mb < 4; ++mb) { const int cc = h * 128 + 16 * (4 * dvh + mb) + 4 * g; gvv[mb] = *(const f32x4*)(gn + cc); rvv[mb] = *(const u32x2*)(P + qrow * 2048 + 512 + cc); }
        asm volatile("s_waitcnt vmcnt(0)" ::: "memory");
        __syncthreads();
        {
            const int j = 8 * wv + (lane >> 3), ch = lane & 7;
            const bf16x8 kr = *(const LAS bf16x8*)(lds + G3_KRAW + (j * 9 + ch) * 16);
            const LAS float* tf = (const LAS float*)(lds + G3_TBF + j * 272 + ch * 32); const LAS float* tb = (const LAS float*)(lds + G3_TBB + j * 272 + ch * 32);
            f32x4 a0 = *(const LAS f32x4*)tf, a1 = *(const LAS f32x4*)(tf + 4), b0 = *(const LAS f32x4*)tb, b1 = *(const LAS f32x4*)(tb + 4);
#pragma unroll
            for (int q = 0; q < 4; ++q) { a0[q] = __builtin_amdgcn_exp2f(-a0[q]); a1[q] = __builtin_amdgcn_exp2f(-a1[q]); b0[q] = __builtin_amdgcn_exp2f(-b0[q]); b1[q] = __builtin_amdgcn_exp2f(-b1[q]); }
            *(LAS bf16x8*)(lds + G3_KIF + (j * 9 + ch) * 16) = scale8(kr, a0, a1); *(LAS bf16x8*)(lds + G3_KIB + (j * 9 + ch) * 16) = scale8(kr, b0, b1);
        }
        bf16x8 qdf[2], qdb[2];
#pragma unroll
        for (int s2 = 0; s2 < 2; ++s2) {
            const LAS float* tf = (const LAS float*)(lds + G3_TBF + iq * 272 + (32 * s2 + 8 * g) * 4); const LAS float* tb = (const LAS float*)(lds + G3_TBB + iq * 272 + (32 * s2 + 8 * g) * 4);
            f32x4 a0 = *(const LAS f32x4*)tf, a1 = *(const LAS f32x4*)(tf + 4), b0 = *(const LAS f32x4*)tb, b1 = *(const LAS f32x4*)(tb + 4);
#pragma unroll
            for (int q = 0; q < 4; ++q) { a0[q] = __builtin_amdgcn_exp2f(a0[q]); a1[q] = __builtin_amdgcn_exp2f(a1[q]); b0[q] = __builtin_amdgcn_exp2f(b0[q]); b1[q] = __builtin_amdgcn_exp2f(b1[q]); }
            qdf[s2] = scale8(qraw[s2], a0, a1); qdb[s2] = scale8(qraw[s2], b0, b1);
        }
        __syncthreads();
        bf16x8 pfrag[2];
#pragma unroll
        for (int t = 0; t < 2; ++t) {
            f32x4 sf[2], sv[2];
#pragma unroll
            for (int u = 0; u < 2; ++u) {
                const int j = 32 * t + 8 * (fr >> 2) + 4 * u + (fr & 3);
                sf[u] = (f32x4){0.f, 0.f, 0.f, 0.f}; sv[u] = (f32x4){0.f, 0.f, 0.f, 0.f};
#pragma unroll
                for (int s2 = 0; s2 < 2; ++s2) {
                    sf[u] = mfma16(*(const LAS bf16x8*)(lds + G3_KIF + (j * 9 + 4 * s2 + g) * 16), qdf[s2], sf[u]);
                    sv[u] = mfma16(*(const LAS bf16x8*)(lds + G3_KIB + (j * 9 + 4 * s2 + g) * 16), qdb[s2], sv[u]);
                }
            }
            f32x4 p0, p1;
#pragma unroll
            for (int ii = 0; ii < 4; ++ii) { const int j0 = 32 * t + 8 * g + ii, j1 = j0 + 4; p0[ii] = (j0 <= iq) ? sf[0][ii] : sv[0][ii]; p1[ii] = (j1 <= iq) ? sf[1][ii] : sv[1][ii]; }
            pfrag[t] = __builtin_bit_cast(bf16x8, pack8(p0, p1));
        }
        f32x4 o[4];
#pragma unroll
        for (int mb = 0; mb < 4; ++mb) o[mb] = (f32x4){0.f, 0.f, 0.f, 0.f};
#pragma unroll
        for (int t = 0; t < 2; ++t)
#pragma unroll
            for (int mb = 0; mb < 4; ++mb) o[mb] = mfma16(*(const LAS bf16x8*)(lds + G3_VT + ((16 * (4 * dvh + mb) + fr) * 9 + 4 * t + g) * 16), pfrag[t], o[mb]);
#pragma unroll
        for (int s2 = 0; s2 < 2; ++s2)
#pragma unroll
            for (int mb = 0; mb < 4; ++mb) {
                o[mb] = mfma16(*(const LAS bf16x8*)(lds + G3_SF + ((16 * (4 * dvh + mb) + fr) * 9 + 4 * s2 + g) * 16), qdf[s2], o[mb]);
                o[mb] = mfma16(*(const LAS bf16x8*)(lds + G3_SB + ((16 * (4 * dvh + mb) + fr) * 9 + 4 * s2 + g) * 16), qdb[s2], o[mb]);
            }
        float ss = 0.f;
#pragma unroll
        for (int mb = 0; mb < 4; ++mb) ss += (o[mb][0] * o[mb][0] + o[mb][1] * o[mb][1]) + (o[mb][2] * o[mb][2] + o[mb][3] * o[mb][3]);
        ss += __shfl_xor(ss, 16); ss += __shfl_xor(ss, 32);
        LAS float* red = (LAS float*)(lds + G3_RED);
        if (g == 0) red[iq * 2 + dvh] = ss;
        __syncthreads();
        if (uid + (int)gridDim.x < nun) g3_dma_unit(lds, P, VAT, DS, BC, uid + (int)gridDim.x, wv, lane);
        const float rstd = rsqrtf((red[iq * 2] + red[iq * 2 + 1]) * (1.0f / 128.0f) + LN_EPS);
#pragma unroll
        for (int mb = 0; mb < 4; ++mb) {
            const int cc = h * 128 + 16 * (4 * dvh + mb) + 4 * g;
            const f32x4 gv = gvv[mb]; const u32x2 rv = rvv[mb];
            const float r0 = silu_f(lo_bf(rv.x)), r1 = silu_f(hi_bf(rv.x)), r2 = silu_f(lo_bf(rv.y)), r3 = silu_f(hi_bf(rv.y));
            u32x2 ov; ov.x = cvt_pk_bf16(o[mb][0] * rstd * gv[0] * r0, o[mb][1] * rstd * gv[1] * r1); ov.y = cvt_pk_bf16(o[mb][2] * rstd * gv[2] * r2, o[mb][3] * rstd * gv[3] * r3);
            *(u32x2*)(MIX + qrow * 1024 + cc) = ov;
        }
    }
    asm volatile("s_waitcnt vmcnt(0)" ::: "memory");
    __syncthreads();
}

constexpr int NAT_K_BYTES = 9 * 64 * 128, NAT_VROW = 73, NAT_V_BYTES = 64 * NAT_VROW * 16, NAT_R_OFF = NAT_K_BYTES + NAT_V_BYTES;
constexpr int NAT_LDS_END = NAT_R_OFF + 8 * 15 * 31 * 4;
__device__ __forceinline__ void nat_dma_k(LAS unsigned char* lds, const bf16_t* P, int wv, int lane, size_t brow, int h, int RB) {
#pragma unroll
    for (int q9 = 0; q9 < 9; ++q9) { const int q = wv + 8 * q9, C = 64 * q + lane, key = C >> 3, slot = C & 7, src = slot ^ ((key ^ (key >> 3)) & 7);
        const int row = min(RB + (key >> 6), 31), tok = row * 64 + (key & 63);
        __builtin_amdgcn_global_load_lds((const unsigned*)(P + (brow + tok) * 2048 + 1536 + h * 64 + src * 8), (LAS unsigned*)(lds + q * 1024), 16, 0, 0); }
}
__device__ __forceinline__ void nat_dma_v(LAS unsigned char* lds, const bf16_t* VBT, int wv, int lane, int bh, int RB) {
    const int pmax = (32 - RB) * 8 - 1;
#pragma unroll
    for (int q10 = 0; q10 < 10; ++q10) { const int q = wv + 8 * q10;
        if (q < NAT_VROW) { const int C = 64 * q + lane, d = C / NAT_VROW, pos = min(C - d * NAT_VROW, min(71, pmax));
            __builtin_amdgcn_global_load_lds((const unsigned*)(VBT + ((size_t)bh * 64 + d) * SEQ + RB * 64 + pos * 8), (LAS unsigned*)(lds + NAT_K_BYTES + q * 1024), 16, 0, 0); } }
}
__device__ __forceinline__ void nat_mfma(LAS unsigned char* lds, const bf16_t* P, const bf16_t* VBT, const float* rpb, bf16_t* MIX) {
    const int tid = opaque_tid(), lane = tid & 63, fr = lane & 15, g = lane >> 4;
    const int wv = __builtin_amdgcn_readfirstlane(tid >> 6);
    LAS float* rl = (LAS float*)(lds + NAT_R_OFF);
    for (int i = tid; i < 8 * 15 * 31; i += 512) rl[i] = rpb[i];
    const int kcl = 8 * (fr >> 2) + (fr & 3);
    const bool xcd_map = (gridDim.x & 7) == 0;
    const int nits = CHB * 8 * 16, kend = xcd_map ? nits / 8 : nits, kstep = xcd_map ? (int)(gridDim.x >> 3) : (int)gridDim.x;
    int k = xcd_map ? (int)(blockIdx.x >> 3) : (int)blockIdx.x;
    if (k < kend) { const int bh = xcd_map ? (k >> 4) * 8 + (int)(blockIdx.x & 7) : (k >> 4), rp = k & 15;
        nat_dma_k(lds, P, wv, lane, (size_t)(bh >> 3) * SEQ, bh & 7, min(max(2 * rp - 4, 0), 24)); }
    for (; k < kend; k += kstep) {
        const int bh = xcd_map ? (k >> 4) * 8 + (int)(blockIdx.x & 7) : (k >> 4), rp = k & 15;
        const int jq = wv & 3, r = rp * 2 + (wv >> 2), h = bh & 7, bl = bh >> 3;
        const int RB = min(max(2 * rp - 4, 0), 24), rs = min(max(r - 4, 0), 24), kb0 = min(max(16 * jq - 8, 0), 32);
        const size_t brow = (size_t)bl * SEQ;
        const size_t qrow = brow + r * 64 + 16 * jq + fr;
        bf16x8 qf[2];
#pragma unroll
        for (int s2 = 0; s2 < 2; ++s2) qf[s2] = *(const bf16x8*)(P + qrow * 2048 + 1024 + h * 64 + 32 * s2 + 8 * g);
        asm volatile("s_waitcnt vmcnt(0)" ::: "memory");
        __syncthreads();
        nat_dma_v(lds, VBT, wv, lane, bh, RB);
        f32x4 sc[8][2];
#pragma unroll
        for (int t = 0; t < 8; ++t)
#pragma unroll
            for (int u = 0; u < 2; ++u) {
                const int kl = (rs - RB + t) * 64 + kb0 + kcl + 4 * u, sw = (kl ^ (kl >> 3)) & 7;
                f32x4 a = (f32x4){0.f, 0.f, 0.f, 0.f};
#pragma unroll
                for (int s2 = 0; s2 < 2; ++s2) a = mfma16(*(const LAS bf16x8*)(lds + kl * 128 + (((s2 * 4 + g) ^ sw) << 4)), qf[s2], a);
                sc[t][u] = a;
            }
        const int qc = 16 * jq + fr, cst = min(max(qc - 8, 0), 48);
        float mx = -3.0e38f;
#pragma unroll
        for (int u = 0; u < 2; ++u)
#pragma unroll
            for (int ii = 0; ii < 4; ++ii) {
                const int kc = kb0 + 8 * g + 4 * u + ii; const bool valid = (kc >= cst) && (kc < cst + 16);
                const int co = min(max(kc - qc + 15, 0), 30);
                const LAS float* rp_ = rl + (h * 15 + rs - r + 7) * 31 + co;
                float bias[8];
#pragma unroll
                for (int t = 0; t < 8; ++t) bias[t] = rp_[t * 31];
#pragma unroll
                for (int t = 0; t < 8; ++t) asm volatile("" : "+v"(bias[t]));
#pragma unroll
                for (int t = 0; t < 8; ++t) { const float v = valid ? sc[t][u][ii] + bias[t] : -1.0e30f; sc[t][u][ii] = v; mx = fmaxf(mx, v); }
            }
        mx = fmaxf(mx, __shfl_xor(mx, 16)); mx = fmaxf(mx, __shfl_xor(mx, 32));
        float sum = 0.f;
        bf16x8 pf[8];
#pragma unroll
        for (int t = 0; t < 8; ++t) {
            f32x4 p0, p1;
#pragma unroll
            for (int ii = 0; ii < 4; ++ii) { p0[ii] = __expf(sc[t][0][ii] - mx); p1[ii] = __expf(sc[t][1][ii] - mx); sum += p0[ii] + p1[ii]; }
            pf[t] = __builtin_bit_cast(bf16x8, pack8(p0, p1));
        }
        sum += __shfl_xor(sum, 16); sum += __shfl_xor(sum, 32);
        const float inv = 1.0f / sum;
        asm volatile("s_waitcnt vmcnt(0)" ::: "memory");
        __syncthreads();
        if (k + kstep < kend) { const int k2 = k + kstep, bh2 = xcd_map ? (k2 >> 4) * 8 + (int)(blockIdx.x & 7) : (k2 >> 4), rp2 = k2 & 15;
            nat_dma_k(lds, P, wv, lane, (size_t)(bh2 >> 3) * SEQ, bh2 & 7, min(max(2 * rp2 - 4, 0), 24)); }
        f32x4 o[4];
#pragma unroll
        for (int mb = 0; mb < 4; ++mb) o[mb] = (f32x4){0.f, 0.f, 0.f, 0.f};
        const int vpos = (rs - RB) * 8 + (kb0 >> 3) + g;
#pragma unroll
        for (int t = 0; t < 8; ++t)
#pragma unroll
            for (int mb = 0; mb < 4; ++mb) o[mb] = mfma16(*(const LAS bf16x8*)(lds + NAT_K_BYTES + (((16 * mb + fr) * NAT_VROW + vpos + 8 * t) << 4)), pf[t], o[mb]);
#pragma unroll
        for (int mb = 0; mb < 4; ++mb) { u32x2 ov; ov.x = cvt_pk_bf16(o[mb][0] * inv, o[mb][1] * inv); ov.y = cvt_pk_bf16(o[mb][2] * inv, o[mb][3] * inv);
            *(u32x2*)(MIX + qrow * 1024 + 512 + h * 64 + 16 * mb + 4 * g) = ov; }
    }
    asm volatile("s_waitcnt vmcnt(0)" ::: "memory");
    __syncthreads();
}

#define XB_TMO      128
#define XB_XCNT(j)  (256  + 64 * (j))
#define XB_XSUB(j)  (1280 + 64 * (j))
#define XB_XGEN(j)  (2304 + 64 * (j))
#define XB_TOP      3328
#define XB_TOPGEN   3392
#define XCD_BAR_WORDS 3456
#define XB_SPIN_CAP (1u << 18)
__device__ __forceinline__ unsigned xb_ld(unsigned* p)              { return __hip_atomic_load(p, __ATOMIC_RELAXED, __HIP_MEMORY_SCOPE_AGENT); }
__device__ __forceinline__ unsigned xb_add(unsigned* p, unsigned v) { return __hip_atomic_fetch_add(p, v, __ATOMIC_RELAXED, __HIP_MEMORY_SCOPE_AGENT); }
__device__ __forceinline__ unsigned xb_xcc_id() { return (unsigned)__builtin_amdgcn_s_getreg((3 << 11) | 20) & 0xFu; }
#define XB_SPIN(cond, bar) do { unsigned _sp = 0; while (cond) { __builtin_amdgcn_s_sleep(1); \
    if ((++_sp & 255u) == 0u) { if (xb_ld(&(bar)[XB_TMO])) break; if (_sp > XB_SPIN_CAP) { atomicAdd(&(bar)[XB_TMO], 1u); break; } } } } while (0)
struct XcdBarrier { unsigned* bar; unsigned x; volatile LAS unsigned* st; };
__device__ __forceinline__ XcdBarrier xcd_barrier_post(unsigned* bar, volatile LAS unsigned* st) {
    XcdBarrier b; b.bar = bar; b.x = xb_xcc_id(); b.st = st;
    if (threadIdx.x == 0) (void)xb_add(&bar[XB_XCNT(b.x)], 1u);
    return b;
}
__device__ __forceinline__ void xcd_barrier_complete(unsigned* bar, unsigned x, unsigned& nloc, unsigned& nx) {
    const unsigned G = gridDim.x * gridDim.y * gridDim.z;
    unsigned sum, cnt, mine, sp = 0u;
    for (;;) {
        sum = 0u; cnt = 0u; mine = 0u;
#pragma unroll
        for (unsigned j = 0; j < 16; ++j) { const unsigned c = xb_ld(&bar[XB_XCNT(j)]); sum += c; cnt += (c > 0u) ? 1u : 0u; mine = (j == x) ? c : mine; }
        if (sum == G) break;
        __builtin_amdgcn_s_sleep(1);
        if ((++sp & 255u) == 0u) { if (xb_ld(&bar[XB_TMO])) break; if (sp > XB_SPIN_CAP) { atomicAdd(&bar[XB_TMO], 1u); break; } }
    }
    nloc = mine > 0u ? mine : 1u; nx = cnt > 0u ? cnt : 1u;
}
__device__ __forceinline__ void xcd_barrier(const XcdBarrier& b) {
    asm volatile("s_waitcnt vmcnt(0)" ::: "memory");
    __syncthreads();
    if (threadIdx.x == 0) {
        unsigned* bar = b.bar;
        __builtin_amdgcn_s_waitcnt(0);
        unsigned nloc = b.st[0], nx = b.st[1];
        if (nloc == 0u) { xcd_barrier_complete(bar, b.x, nloc, nx); b.st[0] = nloc; b.st[1] = nx; }
        const unsigned old = xb_add(&bar[XB_XSUB(b.x)], 1u);
        const unsigned gen = old / nloc;
        if (old + 1u == (gen + 1u) * nloc) {
            __builtin_amdgcn_fence(__ATOMIC_RELEASE, "agent");
            asm volatile("s_waitcnt vmcnt(0)" ::: "memory");
            const unsigned og = xb_add(&bar[XB_TOP], 1u);
            const unsigned tg = og / nx;
            if (og + 1u == (tg + 1u) * nx) xb_add(&bar[XB_TOPGEN], 1u);
            else XB_SPIN(xb_ld(&bar[XB_TOPGEN]) == tg, bar);
            __builtin_amdgcn_fence(__ATOMIC_ACQUIRE, "agent");
            xb_add(&bar[XB_XGEN(b.x)], 1u);
            asm volatile("s_waitcnt vmcnt(0)" ::: "memory");
        } else {
            XB_SPIN(xb_ld(&bar[XB_XGEN(b.x)]) == gen, bar);
            __builtin_amdgcn_fence(__ATOMIC_ACQUIRE, "agent");
            asm volatile("s_waitcnt vmcnt(0)" ::: "memory");
        }
    }
    __syncthreads();
}

constexpr int LDS_BAR_OFF = 160 * 1024 - 64;
static_assert(NAT_LDS_END <= LDS_BAR_OFF, "NAT LDS tiles overlap the barrier words");
__global__ void __launch_bounds__(512) fwd_megakernel(Params p) {
    extern __shared__ __attribute__((aligned(16))) unsigned char lds_raw[];
    LAS unsigned char* lds = (LAS unsigned char*)lds_raw;
    cg::grid_group grid = cg::this_grid();
    unsigned char* ws = p.ws;
#define W_XB ((bf16_t*)(ws + OFF_XB))
#define W_PB ((bf16_t*)(ws + OFF_P))
#define W_KAT ((bf16_t*)(ws + OFF_KAT))
#define W_VAT ((bf16_t*)(ws + OFF_VAT))
#define W_VBT ((bf16_t*)(ws + OFF_VBT))
#define W_LR ((float*)(ws + OFF_LR))
#define W_MIX ((bf16_t*)(ws + OFF_MIX))
#define W_Y1 ((float*)(ws + OFF_Y1))
#define W_Y1B ((bf16_t*)(ws + OFF_Y1B))
#define W_HB ((bf16_t*)(ws + OFF_H))
#define W_ST1 ((float*)(ws + OFF_ST1))
#define W_ST2 ((float*)(ws + OFF_ST2))
#define CVB ((const float*)(ws + OFF_CV))
#define c1in (CVB)
#define c2in (CVB + 2 * NPROJ)
#define c1f1 (CVB + 4 * NPROJ)
#define c2f1 (CVB + 4 * NPROJ + 2 * NF1)
#define GSYNC() do { for (int _r = 0; _r < SYNC_REPS; ++_r) xcd_barrier(xbar); } while (0)
    {   volatile LAS unsigned* stw = (volatile LAS unsigned*)(lds + LDS_BAR_OFF);
        if (threadIdx.x < 4) stw[threadIdx.x] = 0u;
        __syncthreads(); }
    const XcdBarrier xbar = xcd_barrier_post((unsigned*)(ws + OFF_BAR), (volatile LAS unsigned*)(lds + LDS_BAR_OFF));
    pg8::StaticOrder S;

#ifndef NO_PRO
    prologue_weights(p, lds);
#endif
    for (int c = 0; c < NCHUNK; ++c) {
        float* OUT = p.out + (size_t)c * TC * DM;
        convert_x(p.xp, p.xs, (size_t)c * TC, W_XB);
        if (c > 0) final_ln(p.out + (size_t)(c - 1) * TC * DM, W_Y1B, W_ST2, p.ln2g + DM, p.ln2b + DM);
        if (c == 0) grid.sync(); else GSYNC();
        for (int l = 0; l < 2; ++l) {
#ifndef NO_G1
            {   EpiProj E; E.P = W_PB; E.KAT = W_KAT; E.VAT = W_VAT; E.VBT = W_VBT; E.LR = W_LR;
                E.st = l ? W_ST2 : nullptr; E.c1 = c1in + l * NPROJ; E.c2 = c2in + l * NPROJ;
                pg8::Gemm g; g.A = W_XB; g.Bt = (const bf16_t*)(ws + OFF_WIN) + (size_t)l * NPROJ * DM; g.M = TC; g.N = NPROJ; g.K = DM;
                S.init(TC, NPROJ, gridDim.x, blockIdx.x);
                for (int rr = 0; rr < GEMM_REPS; ++rr) pg8::gemm_phase(lds, g, S, E); }
#endif
            GSYNC();
#ifndef NO_MIX
            for (int rep = 0; rep < MIX_REPS; ++rep) {
            for (int rr = 0; rr < NAT_REPS; ++rr) nat_mfma(lds, W_PB, W_VBT, p.rpb + (size_t)l * 8 * 15 * 31, W_MIX);
            for (int rr = 0; rr < G1_REPS; ++rr) gla_g1(lds, W_KAT, W_VAT, W_LR, p.gw2 + (size_t)l * 2 * 16 * 256, p.gb + (size_t)l * 2 * 256, (bf16_t*)(ws + OFF_DS), (float*)(ws + OFF_DEC), (float*)(ws + OFF_BC));
            GSYNC();
            gla_g2(lds, (bf16_t*)(ws + OFF_DS), (const float*)(ws + OFF_DEC));
            GSYNC();
            for (int rr = 0; rr < G3_REPS; ++rr) gla_g3(lds, W_PB, W_VAT, (const bf16_t*)(ws + OFF_DS), (const float*)(ws + OFF_BC), p.gng + (size_t)l * 512, W_MIX);
            GSYNC();
            }
#endif
#ifndef NO_G2
            {   EpiOut E; E.xres = W_XB; E.xp = p.xp; E.xs = p.xs; E.grow0 = (size_t)c * TC; E.st2 = l ? W_ST2 : nullptr; E.g2 = p.ln2g; E.b2 = p.ln2b; E.Y1B = W_Y1B; E.st1 = W_ST1;
                pg8::Gemm g; g.A = W_MIX; g.Bt = (const bf16_t*)(ws + OFF_WOUT) + (size_t)l * DM * DM; g.M = TC; g.N = DM; g.K = DM;
                S.init(TC, DM, gridDim.x, blockIdx.x);
                pg8::gemm_phase(lds, g, S, E); }
            GSYNC();
#endif
#ifndef NO_G3
            {   EpiF1 E; E.st1 = W_ST1; E.c1 = c1f1 + l * NF1; E.c2 = c2f1 + l * NF1; E.H = W_HB;
                pg8::Gemm g; g.A = W_Y1B; g.Bt = (const bf16_t*)(ws + OFF_WF1) + (size_t)l * NF1 * DM; g.M = TC; g.N = NF1; g.K = DM;
                S.init(TC, NF1, gridDim.x, blockIdx.x);
                for (int rr = 0; rr < GEMM_REPS; ++rr) pg8::gemm_phase(lds, g, S, E); }
            GSYNC();
#endif
#ifndef NO_G4
            {   EpiF2 E; E.Y1B = W_Y1B; E.st1 = W_ST1; E.g1 = p.ln1g + l * DM; E.b1 = p.ln1b + l * DM; E.OUT = OUT; E.XB = l ? W_Y1B : W_XB; E.st2 = W_ST2;
                pg8::Gemm g; g.A = W_HB; g.Bt = (const bf16_t*)(ws + OFF_WF2) + (size_t)l * DM * KF2; g.M = TC; g.N = DM; g.K = KF2;
                S.init(TC, DM, gridDim.x, blockIdx.x);
                pg8::gemm_phase(lds, g, S, E); }
#endif
            GSYNC();
        }
    }
    final_ln(p.out + (size_t)(NCHUNK - 1) * TC * DM, W_Y1B, W_ST2, p.ln2g + DM, p.ln2b + DM);
}

extern "C" void kernel_launch(void* const* d_in, const int* in_sizes, int n_in, void* d_out, int out_size, void* d_ws, size_t ws_size, hipStream_t stream) {
    constexpr size_t kLds = 160 * 1024;
    static int grid_blocks = 0;
    if (!grid_blocks) {
        int dev = 0, cus = 0, per_cu = 0;
        (void)hipGetDevice(&dev);
        (void)hipDeviceGetAttribute(&cus, hipDeviceAttributeMultiprocessorCount, dev);
        (void)hipFuncSetAttribute((const void*)fwd_megakernel, hipFuncAttributeMaxDynamicSharedMemorySize, (int)kLds);
        (void)hipOccupancyMaxActiveBlocksPerMultiprocessor(&per_cu, (const void*)fwd_megakernel, 512, kLds);
        if (per_cu < 1) per_cu = 1;
        grid_blocks = cus;
        if (n_in != 14 || ws_size < WS_END) { fprintf(stderr, "kernel_launch: unexpected n_in %d or ws_size %zu < %zu\n", n_in, ws_size, (size_t)WS_END); grid_blocks = -1; }
    }
    if (grid_blocks < 0) return;
    (void)hipMemsetAsync((unsigned char*)d_ws + OFF_CV, 0, al256(CV_BYTES) + BAR_BYTES, stream);
    Params p{};
    p.xp = (const float*)d_in[0]; p.xs = (const float*)d_in[1]; p.w_in = (const float*)d_in[2]; p.gw2 = (const float*)d_in[3]; p.gb = (const float*)d_in[4];
    p.gng = (const float*)d_in[5]; p.rpb = (const float*)d_in[6]; p.w_out = (const float*)d_in[7]; p.ln1g = (const float*)d_in[8]; p.ln1b = (const float*)d_in[9];
    p.wf1 = (const float*)d_in[10]; p.wf2 = (const float*)d_in[11]; p.ln2g = (const float*)d_in[12]; p.ln2b = (const float*)d_in[13];
    p.out = (float*)d_out; p.ws = (unsigned char*)d_ws;
    void* args[] = {&p};
    hipError_t e = hipLaunchCooperativeKernel((void*)fwd_megakernel, dim3(grid_blocks), dim3(512), args, kLds, stream);
    if (e != hipSuccess) fprintf(stderr, "cooperative launch failed: %s (grid %d)\n", hipGetErrorString(e), grid_blocks);
}
```

```cpp
#include <hip/hip_runtime.h>
#include <hip/hip_cooperative_groups.h>
#include <cstdio>
#ifndef NAT_REPS
#define NAT_REPS 1
#endif
#ifndef G1_REPS
#define G1_REPS 1
#endif
#ifndef G3_REPS
#define G3_REPS 1
#endif
#ifndef GEMM_REPS
#define GEMM_REPS 1
#endif
#ifndef MIX_REPS
#define MIX_REPS 1
#endif
#ifndef SYNC_REPS
#define SYNC_REPS 1
#endif
#ifndef NAIVE_NAT
#define NAIVE_NAT 0
#endif
#ifndef NAIVE_GLA
#define NAIVE_GLA 0
#endif
namespace cg = cooperative_groups;

#define LAS __attribute__((address_space(3)))
typedef unsigned short bf16_t;
typedef short bf16x8 __attribute__((ext_vector_type(8)));
typedef float f32x4 __attribute__((ext_vector_type(4)));
typedef unsigned u32x4 __attribute__((ext_vector_type(4)));
typedef unsigned u32x2 __attribute__((ext_vector_type(2)));

constexpr int DM = 1024, SEQ = 2048, CHB = 24, TC = CHB * SEQ, NCHUNK = 2, NPROMPT_ROWS = 32 * SEQ;
constexpr int NPROJ = 3328, NF1 = 5632, KF2 = 2816;
constexpr float ALPHA = 1.41421356237309515f, LN_EPS = 1e-5f;

constexpr size_t al256(size_t x) { return (x + 255) & ~(size_t)255; }
constexpr size_t OFF_WIN = 0;
constexpr size_t OFF_WOUT = OFF_WIN + al256(2ull * NPROJ * DM * 2);
constexpr size_t OFF_WF1 = OFF_WOUT + al256(2ull * DM * DM * 2);
constexpr size_t OFF_WF2 = OFF_WF1 + al256(2ull * NF1 * DM * 2);
constexpr size_t OFF_CV = OFF_WF2 + al256(2ull * DM * KF2 * 2);
constexpr size_t CV_BYTES = (2ull * NPROJ * 2 + 2ull * NF1 * 2) * 4;
constexpr size_t OFF_BAR = OFF_CV + al256(CV_BYTES);
constexpr size_t BAR_BYTES = 3456 * 4;
constexpr size_t OFF_XB = OFF_BAR + al256(BAR_BYTES);
constexpr size_t OFF_P = OFF_XB + al256((size_t)TC * 1024 * 2);
constexpr size_t OFF_KAT = OFF_P + al256((size_t)TC * 2048 * 2);
constexpr size_t OFF_VAT = OFF_KAT + al256((size_t)TC * 256 * 2);
constexpr size_t OFF_VBT = OFF_VAT + al256((size_t)TC * 512 * 2);
constexpr size_t OFF_LR = OFF_VBT + al256((size_t)TC * 512 * 2);
constexpr size_t OFF_MIX = OFF_LR + al256((size_t)TC * 32 * 4);
constexpr size_t OFF_Y1 = OFF_MIX + al256((size_t)TC * 1024 * 2);
constexpr size_t OFF_Y1B = OFF_Y1 + al256((size_t)TC * 1024 * 4);
constexpr size_t OFF_ST1 = OFF_Y1B + al256((size_t)TC * 1024 * 2);
constexpr size_t OFF_ST2 = OFF_ST1 + al256((size_t)TC * 32 * 4);
constexpr size_t OFF_DEC = OFF_ST2 + al256((size_t)TC * 32 * 4);
constexpr size_t WS_END = OFF_DEC + al256((size_t)CHB * 4 * 32 * 2 * 64 * 4);
constexpr size_t OFF_H = OFF_P;
constexpr size_t OFF_BC = OFF_Y1;
constexpr size_t OFF_DS = OFF_Y1B;
static_assert((size_t)TC * KF2 * 2 <= OFF_LR - OFF_P, "H does not fit its alias");
static_assert((size_t)CHB * 4 * 32 * 2 * 8192 * 2 <= (size_t)TC * 1024 * 2, "DS does not fit its alias");

struct Params {
    const float *xp, *xs, *w_in, *gw2, *gb, *gng, *rpb, *w_out, *ln1g, *ln1b, *wf1, *wf2, *ln2g, *ln2b;
    float* out; unsigned char* ws;
};

typedef __bf16 bf16x2_t __attribute__((ext_vector_type(2)));
typedef float f32x2_t __attribute__((ext_vector_type(2)));
__device__ __forceinline__ unsigned cvt_pk_bf16(float lo, float hi) { const f32x2_t f = {lo, hi}; const bf16x2_t v = __builtin_convertvector(f, bf16x2_t); return __builtin_bit_cast(unsigned, v); }
__device__ __forceinline__ bf16_t f2bf(float x) { return (bf16_t)(cvt_pk_bf16(x, 0.f) & 0xffffu); }
__device__ __forceinline__ float bf2f(bf16_t h) { return __uint_as_float(((unsigned)h) << 16); }
__device__ __forceinline__ float lo_bf(unsigned x) { return __uint_as_float(x << 16); }
__device__ __forceinline__ float hi_bf(unsigned x) { return __uint_as_float(x & 0xffff0000u); }
__device__ __forceinline__ float silu_f(float x) { return x * __builtin_amdgcn_rcpf(1.0f + __expf(-x)); }
__device__ __forceinline__ void row_stats(const float* st, int row, int fq, float& mu, float& rs) {
    const f32x4 a = *(const f32x4*)(st + (size_t)row * 32 + fq * 8), b = *(const f32x4*)(st + (size_t)row * 32 + fq * 8 + 4);
    float s = (a[0] + a[2]) + (b[0] + b[2]), q = (a[1] + a[3]) + (b[1] + b[3]);
    s += __shfl_xor(s, 16); s += __shfl_xor(s, 32); q += __shfl_xor(q, 16); q += __shfl_xor(q, 32);
    mu = s * (1.0f / 1024.0f); const float var = fmaxf(q * (1.0f / 1024.0f) - mu * mu, 0.f); rs = rsqrtf(var + LN_EPS);
}

__device__ __forceinline__ int opaque_tid() { int t = threadIdx.x; asm volatile("" : "+v"(t)); return t; }
__device__ __forceinline__ const float* xrow_ptr(const float* xp, const float* xs, size_t grow) {
    return grow < (size_t)NPROMPT_ROWS ? xp + grow * DM : xs + (grow - NPROMPT_ROWS) * DM;
}
namespace pg8 {
constexpr int BM = 256, BK = 64, HALF = 128, HTB = HALF * BK * 2, STAGE_BYTES = 8 * HTB, NXCD = 8, WGM = 8;
__host__ __device__ __forceinline__ int lds_byte(int r, int c) { const int st = (r >> 4) * 2 + (c >> 5), rr = r & 15, cc = c & 31, ob = rr * 64 + cc * 2; return st * 1024 + (ob ^ (((ob >> 9) & 1) << 5)); }
__host__ __device__ __forceinline__ void stage_rc(int b, int& R, int& C) { const int st = b / 1024, sb = b % 1024, swz = sb ^ (((sb >> 9) & 1) << 5); R = (st >> 1) * 16 + swz / 64; C = (st & 1) * 32 + (swz % 64) / 2; }
__host__ __device__ __forceinline__ int perm32(int rho) { const int n = rho >> 4, i = rho & 15; return 8 * (i >> 2) + 4 * n + (i & 3); }
struct Unit { int pm, pn; };
struct Gemm { const bf16_t* A; const bf16_t* Bt; int M, N, K; };
struct StaticOrder {
    int nM, nN, nwg, G, c;
    __host__ __device__ void init(int M, int N, int G_, int c_) { nM = M / BM; nN = N / BM; nwg = nM * nN; G = G_; c = c_; }
    __host__ __device__ bool next(int i, Unit& u) const {
        const long L = (long)i * G + c; if (L >= nwg) return false;
        int wgid = (int)L; { const int q = nwg / NXCD, r = nwg % NXCD, xcd = wgid % NXCD, off = wgid / NXCD; wgid = (xcd < r ? xcd * (q + 1) : r * (q + 1) + (xcd - r) * q) + off; }
        const int nig = WGM * nN, gid = wgid / nig, fm = gid * WGM, gsz = (nM - fm) < WGM ? (nM - fm) : WGM;
        u.pm = fm + ((wgid % nig) % gsz); u.pn = (wgid % nig) / gsz; return true;
    }
};
template <class Epi>
__device__ __forceinline__ void gemm_phase(LAS unsigned char* lds, const Gemm g, const StaticOrder& S, const Epi& E) {
    const int tid = opaque_tid(), wid = __builtin_amdgcn_readfirstlane(tid >> 6), lane = tid & 63, wr = wid >> 2, wc = wid & 3, fr = lane & 15, fq = lane >> 4;
    const int K = g.K, nt = K / BK;
    unsigned voffA[2], voffB[2];
#pragma unroll
    for (int i = 0; i < 2; ++i) { int R, C; stage_rc(tid * 16 + i * 8192, R, C); const int Rb = Epi::PERM ? ((R & ~31) + perm32(R & 31)) : R;
        voffA[i] = (unsigned)(R * K + C) * 2u; voffB[i] = (unsigned)(Rb * K + C) * 2u; }
    const size_t kstep = (size_t)(BK * 2);
    const size_t hstep = (size_t)HALF * K * 2;
    const size_t tstep = 2 * hstep;
    const unsigned ldsw = (unsigned)wid * 1024u;
    const int aoff = lds_byte(wr * 64 + fr, fq * 8), boff = lds_byte(wc * 32 + fr, fq * 8);
#define PG8_SA(b, h) (((b) * 2 + (h)) * HTB)
#define PG8_SB(b, h) ((4 + (b) * 2 + (h)) * HTB)
#define PG8_STAGE(bufoff, gbase, voff) do { _Pragma("unroll") for (int _i = 0; _i < 2; ++_i) \
        __builtin_amdgcn_global_load_lds((const unsigned*)((const char*)(gbase) + (voff)[_i]), (LAS unsigned*)(lds + (bufoff) + ldsw + _i * 8192), 16, 0, 0); } while (0)
#define PG8_LDA(dst, b, h) do { _Pragma("unroll") for (int m = 0; m < 4; ++m) _Pragma("unroll") for (int k = 0; k < 2; ++k) dst[m][k] = *(const LAS bf16x8*)(lds + PG8_SA(b, h) + aoff + m * 2048 + k * 1024); } while (0)
#define PG8_LDB(dst, b, h) do { _Pragma("unroll") for (int n = 0; n < 2; ++n) _Pragma("unroll") for (int k = 0; k < 2; ++k) dst[n][k] = *(const LAS bf16x8*)(lds + PG8_SB(b, h) + boff + n * 2048 + k * 1024); } while (0)
#define PG8_MMA(ai, bj, At, Bt) do { __builtin_amdgcn_s_setprio(1); _Pragma("unroll") for (int m = 0; m < 4; ++m) _Pragma("unroll") for (int n = 0; n < 2; ++n) _Pragma("unroll") for (int k = 0; k < 2; ++k) \
        acc[ai][bj][m][n] = __builtin_amdgcn_mfma_f32_16x16x32_bf16(Bt[n][k], At[m][k], acc[ai][bj][m][n], 0, 0, 0); __builtin_amdgcn_s_setprio(0); } while (0)
#define PG8_WAIT_V(n) asm volatile("s_waitcnt vmcnt(" #n ")" ::: "memory")
#define PG8_WAIT_L(n) asm volatile("s_waitcnt lgkmcnt(" #n ")" ::: "memory")
#define PG8_BAR __builtin_amdgcn_s_barrier()
#define PG8_SCHED __builtin_amdgcn_sched_barrier(0)
    Unit cur, nxt; int ui = 0;
    if (!S.next(0, cur)) return;
    f32x4 acc[2][2][4][2];
#pragma unroll
    for (int a = 0; a < 2; ++a)
#pragma unroll
        for (int b = 0; b < 2; ++b)
#pragma unroll
            for (int m = 0; m < 4; ++m)
#pragma unroll
                for (int n = 0; n < 2; ++n) acc[a][b][m][n] = (f32x4){0.f, 0.f, 0.f, 0.f};
    bf16x8 At[4][2], B0[2][2], B1[2][2];
    const char* cA = (const char*)g.A + (size_t)cur.pm * tstep; const char* cB = (const char*)g.Bt + (size_t)cur.pn * tstep;
    PG8_STAGE(PG8_SB(0, 0), cB, voffB); PG8_STAGE(PG8_SA(0, 0), cA, voffA); PG8_STAGE(PG8_SB(0, 1), cB + hstep, voffB); PG8_STAGE(PG8_SA(0, 1), cA + hstep, voffA);
    if (wr == 1) PG8_BAR;
    PG8_WAIT_V(4); PG8_BAR;
    PG8_STAGE(PG8_SB(1, 0), cB + kstep, voffB); PG8_STAGE(PG8_SA(1, 0), cA + kstep, voffA); PG8_STAGE(PG8_SB(1, 1), cB + hstep + kstep, voffB);
    PG8_WAIT_V(6); PG8_BAR;
    for (;;) {
        const bool has_next = S.next(ui + 1, nxt);
        const char* nA = has_next ? (const char*)g.A + (size_t)nxt.pm * tstep : cA; const char* nB = has_next ? (const char*)g.Bt + (size_t)nxt.pn * tstep : cB;
        for (int t = 0; t < nt; t += 2) {
            const bool last = (t == nt - 2);
            const char* a1 = cA + (size_t)(t + 1) * kstep;
            const char* a2 = last ? nA : cA + (size_t)(t + 2) * kstep; const char* b2 = last ? nB : cB + (size_t)(t + 2) * kstep;
            const char* a3 = a2 + kstep; const char* b3 = b2 + kstep;
            PG8_LDB(B0, 0, 0); PG8_SCHED; PG8_LDA(At, 0, 0); PG8_STAGE(PG8_SA(1, 1), a1 + hstep, voffA);
            PG8_WAIT_L(8); PG8_BAR; PG8_WAIT_L(0); PG8_MMA(0, 0, At, B0); PG8_BAR; PG8_SCHED;
            PG8_LDB(B1, 0, 1); PG8_STAGE(PG8_SB(0, 0), b2, voffB);
            PG8_BAR; PG8_WAIT_L(0); PG8_MMA(0, 1, At, B1); PG8_BAR;
            PG8_LDA(At, 0, 1); PG8_STAGE(PG8_SA(0, 0), a2, voffA);
            PG8_BAR; PG8_WAIT_L(0); PG8_MMA(1, 0, At, B0); PG8_BAR; PG8_SCHED;
            PG8_STAGE(PG8_SB(0, 1), b2 + hstep, voffB);
            PG8_WAIT_V(6); PG8_BAR; PG8_MMA(1, 1, At, B1); PG8_BAR;
            PG8_LDB(B0, 1, 0); PG8_SCHED; PG8_LDA(At, 1, 0); PG8_STAGE(PG8_SA(0, 1), a2 + hstep, voffA);
            PG8_WAIT_L(8); PG8_BAR; PG8_WAIT_L(0); PG8_MMA(0, 0, At, B0); PG8_BAR; PG8_SCHED;
            PG8_LDB(B1, 1, 1); PG8_STAGE(PG8_SB(1, 0), b3, voffB);
            PG8_BAR; PG8_WAIT_L(0); PG8_MMA(0, 1, At, B1); PG8_BAR;
            PG8_LDA(At, 1, 1); PG8_STAGE(PG8_SA(1, 0), a3, voffA);
            PG8_BAR; PG8_WAIT_L(0); PG8_MMA(1, 0, At, B0); PG8_BAR; PG8_SCHED;
            PG8_STAGE(PG8_SB(1, 1), b3 + hstep, voffB);
            PG8_WAIT_V(6); PG8_BAR; PG8_MMA(1, 1, At, B1); PG8_BAR;
        }
        E(acc, cur, wr, wc, fr, fq);
        if (!has_next) break;
#pragma unroll
        for (int a = 0; a < 2; ++a)
#pragma unroll
            for (int b = 0; b < 2; ++b)
#pragma unroll
                for (int m = 0; m < 4; ++m)
#pragma unroll
                    for (int n = 0; n < 2; ++n) acc[a][b][m][n] = (f32x4){0.f, 0.f, 0.f, 0.f};
        cur = nxt; cA = nA; cB = nB; ++ui;
    }
    PG8_WAIT_V(0);
    if (wr == 0) PG8_BAR;
    PG8_BAR;
#undef PG8_SA
#undef PG8_SB
#undef PG8_STAGE
#undef PG8_LDA
#undef PG8_LDB
#undef PG8_MMA
#undef PG8_WAIT_V
#undef PG8_WAIT_L
#undef PG8_BAR
#undef PG8_SCHED
}
}
using pg8::Unit;

__device__ __forceinline__ u32x4 pack8(const f32x4 a, const f32x4 b) { u32x4 w; w.x = cvt_pk_bf16(a[0], a[1]); w.y = cvt_pk_bf16(a[2], a[3]); w.z = cvt_pk_bf16(b[0], b[1]); w.w = cvt_pk_bf16(b[2], b[3]); return w; }
__device__ __forceinline__ void store_T8(bf16_t* p, const f32x4 a, const f32x4 b, const int odd) {
    bf16_t* q = odd ? p + 4 * (size_t)SEQ - 1 : p;
#pragma unroll
    for (int j = 0; j < 4; ++j) {
        const float pa = __shfl_xor(a[j], 1), pb = __shfl_xor(b[j], 1);
        *(unsigned*)(q + (size_t)j * SEQ) = odd ? cvt_pk_bf16(pb, b[j]) : cvt_pk_bf16(a[j], pa);
    }
}

struct EpiProj {
    static constexpr bool PERM = true;
    bf16_t *P, *KAT, *VAT, *VBT; float* LR;
    const float *st, *c1, *c2;
    __device__ __forceinline__ void operator()(const f32x4 (&acc)[2][2][4][2], const Unit& u, int wr, int wc, int fr_, int fq_) const {
        int fr = fr_, fq = fq_; asm volatile("" : "+v"(fr), "+v"(fq));
        const int pn = u.pn, lc = wc * 32 + fq * 8, bl = u.pm >> 3, tok0 = (u.pm & 7) * 256;
        f32x4 c1v[2][2], c2v[2][2];
#pragma unroll
        for (int bj = 0; bj < 2; ++bj)
#pragma unroll
            for (int n = 0; n < 2; ++n) {
                if (st) { c1v[bj][n] = *(const f32x4*)(c1 + pn * 256 + bj * 128 + lc + 4 * n); c2v[bj][n] = *(const f32x4*)(c2 + pn * 256 + bj * 128 + lc + 4 * n); }
                else { c1v[bj][n] = (f32x4){0.f, 0.f, 0.f, 0.f}; c2v[bj][n] = (f32x4){0.f, 0.f, 0.f, 0.f}; } }
        const bool isT = (pn == 1) || (pn == 2) || (pn == 3) || (pn == 10) || (pn == 11);
        const bool isP = !(pn == 2 || pn == 3 || pn >= 10);
        const int pcol0 = (pn < 2 ? pn : pn - 2) * 256;
        bf16_t* tb[2];
#pragma unroll
        for (int bj = 0; bj < 2; ++bj) { const int col = bj * 128 + lc;
            if (pn == 1) tb[bj] = KAT + ((size_t)(bl * 4 + (col >> 6)) * 64 + (col & 63)) * SEQ;
            else if (pn < 4) { const int cv = (pn - 2) * 256 + col; tb[bj] = VAT + ((size_t)(bl * 4 + (cv >> 7)) * 128 + (cv & 127)) * SEQ; }
            else { const int cv = (pn - 10) * 256 + col; tb[bj] = VBT + ((size_t)(bl * 8 + (cv >> 6)) * 64 + (cv & 63)) * SEQ; } }
#pragma unroll
        for (int ai = 0; ai < 2; ++ai)
#pragma unroll
            for (int m = 0; m < 4; ++m) {
                const int rt = ai * 128 + m * 16 + wr * 64 + fr, grow = u.pm * 256 + rt, tok = tok0 + rt;
                float mu = 0.f, rs = 1.f; if (st) row_stats(st, grow, fq, mu, rs);
#pragma unroll
                for (int bj = 0; bj < 2; ++bj) {
                    const f32x4 v0 = (acc[ai][bj][m][0] - mu * c1v[bj][0]) * rs + c2v[bj][0];
                    const f32x4 v1 = (acc[ai][bj][m][1] - mu * c1v[bj][1]) * rs + c2v[bj][1];
                    const int col = bj * 128 + lc;
                    if (pn == 12) { if (col < 32) { *(f32x4*)(LR + (size_t)grow * 32 + col) = v0; *(f32x4*)(LR + (size_t)grow * 32 + col + 4) = v1; } }
                    else {
                        if (isP) *(u32x4*)(P + (size_t)grow * 2048 + pcol0 + col) = pack8(v0, v1);
                        if (isT) store_T8(tb[bj] + tok, v0, v1, fr & 1);
                    }
                }
            }
    }
};

struct EpiOut {
    static constexpr bool PERM = true;
    const bf16_t* xres; const float *xp, *xs; size_t grow0; const float *st2, *g2, *b2;
    bf16_t* Y1B; float* st1;
    __device__ __forceinline__ void operator()(const f32x4 (&acc)[2][2][4][2], const Unit& u, int wr, int wc, int fr_, int fq_) const {
        int fr = fr_, fq = fq_; asm volatile("" : "+v"(fr), "+v"(fq));
        const int lc = wc * 32 + fq * 8;
        const float* xb = xrow_ptr(xp, xs, grow0 + (size_t)u.pm * 256) - (size_t)u.pm * 256 * 1024;
        f32x4 gv[2][2], bv[2][2];
#pragma unroll
        for (int bj = 0; bj < 2; ++bj)
#pragma unroll
            for (int n = 0; n < 2; ++n) { const int col = u.pn * 256 + bj * 128 + lc + 4 * n;
                if (st2) { gv[bj][n] = *(const f32x4*)(g2 + col); bv[bj][n] = *(const f32x4*)(b2 + col); } else { gv[bj][n] = (f32x4){1.f, 1.f, 1.f, 1.f}; bv[bj][n] = (f32x4){0.f, 0.f, 0.f, 0.f}; } }
#pragma unroll
        for (int am = 0; am < 4; ++am) { const int ai = am >> 1, m0 = (am & 1) * 2;
            f32x4 xr[2][2][2]; float mu[2], rs[2];
#pragma unroll
            for (int mm = 0; mm < 2; ++mm) { const int m = mm; const int mg = m0 + mm;
                const int grow = u.pm * 256 + ai * 128 + mg * 16 + wr * 64 + fr;
#pragma unroll
                for (int bj = 0; bj < 2; ++bj) { const size_t off = (size_t)grow * 1024 + u.pn * 256 + bj * 128 + lc;
                    if (st2) { const u32x4 w = *(const u32x4*)(xres + off);
                        xr[m][bj][0] = (f32x4){lo_bf(w.x), hi_bf(w.x), lo_bf(w.y), hi_bf(w.y)}; xr[m][bj][1] = (f32x4){lo_bf(w.z), hi_bf(w.z), lo_bf(w.w), hi_bf(w.w)}; }
                    else { xr[m][bj][0] = *(const f32x4*)(xb + off); xr[m][bj][1] = *(const f32x4*)(xb + off + 4); } }
                mu[m] = 0.f; rs[m] = 1.f; if (st2) row_stats(st2, grow, fq, mu[m], rs[m]);
            }
            asm volatile("" ::: "memory");
#pragma unroll
            for (int mm = 0; mm < 2; ++mm) { const int m = mm; const int mg = m0 + mm;
                const int grow = u.pm * 256 + ai * 128 + mg * 16 + wr * 64 + fr;
                float s = 0.f, ss = 0.f;
#pragma unroll
                for (int bj = 0; bj < 2; ++bj) { const size_t off = (size_t)grow * 1024 + u.pn * 256 + bj * 128 + lc;
                    const f32x4 x0 = (xr[m][bj][0] - mu[m]) * rs[m] * gv[bj][0] + bv[bj][0], x1 = (xr[m][bj][1] - mu[m]) * rs[m] * gv[bj][1] + bv[bj][1];
                    const f32x4 y0 = x0 * ALPHA + acc[ai][bj][mg][0], y1 = x1 * ALPHA + acc[ai][bj][mg][1];
                    *(u32x4*)(Y1B + off) = pack8(y0, y1);
                    s += (y0[0] + y0[1]) + (y0[2] + y0[3]) + (y1[0] + y1[1]) + (y1[2] + y1[3]);
                    ss += (y0[0] * y0[0] + y0[1] * y0[1]) + (y0[2] * y0[2] + y0[3] * y0[3]) + (y1[0] * y1[0] + y1[1] * y1[1]) + (y1[2] * y1[2] + y1[3] * y1[3]);
                }
                s += __shfl_xor(s, 16); s += __shfl_xor(s, 32); ss += __shfl_xor(ss, 16); ss += __shfl_xor(ss, 32);
                if (fq == 0) { f32x2_t o2 = {s, ss}; *(f32x2_t*)(st1 + (size_t)grow * 32 + (u.pn * 4 + wc) * 2) = o2; }
            }
        }
    }
};

struct EpiF1 {
    static constexpr bool PERM = true;
    const float *st1, *c1, *c2; bf16_t* H;
    __device__ __forceinline__ void operator()(const f32x4 (&acc)[2][2][4][2], const Unit& u, int wr, int wc, int fr_, int fq_) const {
        int fr = fr_, fq = fq_; asm volatile("" : "+v"(fr), "+v"(fq));
        const int lc = wc * 32 + fq * 8;
        f32x4 c1v[2][2], c2v[2][2];
#pragma unroll
        for (int bj = 0; bj < 2; ++bj)
#pragma unroll
            for (int n = 0; n < 2; ++n) { c1v[bj][n] = *(const f32x4*)(c1 + u.pn * 256 + bj * 128 + lc + 4 * n); c2v[bj][n] = *(const f32x4*)(c2 + u.pn * 256 + bj * 128 + lc + 4 * n); }
        float mus[8], rss[8];
#pragma unroll
        for (int q = 0; q < 8; ++q) row_stats(st1, u.pm * 256 + (q >> 2) * 128 + (q & 3) * 16 + wr * 64 + fr, fq, mus[q], rss[q]);
        asm volatile("" ::: "memory");
#pragma unroll
        for (int ai = 0; ai < 2; ++ai)
#pragma unroll
            for (int m = 0; m < 4; ++m) {
                const int grow = u.pm * 256 + ai * 128 + m * 16 + wr * 64 + fr;
                const float mu = mus[ai * 4 + m], rs = rss[ai * 4 + m];
                f32x4 h[2];
#pragma unroll
                for (int n = 0; n < 2; ++n) {
                    const f32x4 g = (acc[ai][0][m][n] - mu * c1v[0][n]) * rs + c2v[0][n];
                    const f32x4 up = (acc[ai][1][m][n] - mu * c1v[1][n]) * rs + c2v[1][n];
#pragma unroll
                    for (int j = 0; j < 4; ++j) h[n][j] = silu_f(g[j]) * up[j];
                }
                *(u32x4*)(H + (size_t)grow * KF2 + u.pn * 128 + lc) = pack8(h[0], h[1]);
            }
    }
};

struct EpiF2 {
    static constexpr bool PERM = true;
    const bf16_t* Y1B; const float *st1, *g1, *b1; float* OUT; bf16_t* XB; float* st2;
    __device__ __forceinline__ void operator()(const f32x4 (&acc)[2][2][4][2], const Unit& u, int wr, int wc, int fr_, int fq_) const {
        int fr = fr_, fq = fq_; asm volatile("" : "+v"(fr), "+v"(fq));
        const int lc = wc * 32 + fq * 8;
        f32x4 gv[2][2], bv[2][2];
#pragma unroll
        for (int bj = 0; bj < 2; ++bj)
#pragma unroll
            for (int n = 0; n < 2; ++n) { const int col = u.pn * 256 + bj * 128 + lc + 4 * n; gv[bj][n] = *(const f32x4*)(g1 + col); bv[bj][n] = *(const f32x4*)(b1 + col); }
#pragma unroll
        for (int am = 0; am < 4; ++am) { const int ai = am >> 1, m0 = (am & 1) * 2;
            u32x4 w[2][2]; float mu[2], rs[2];
#pragma unroll
            for (int mm = 0; mm < 2; ++mm) { const int m = mm; const int mg = m0 + mm;
                const int grow = u.pm * 256 + ai * 128 + mg * 16 + wr * 64 + fr;
#pragma unroll
                for (int bj = 0; bj < 2; ++bj) w[m][bj] = *(const u32x4*)(Y1B + (size_t)grow * 1024 + u.pn * 256 + bj * 128 + lc);
                row_stats(st1, grow, fq, mu[m], rs[m]);
            }
            asm volatile("" ::: "memory");
#pragma unroll
            for (int mm = 0; mm < 2; ++mm) { const int m = mm; const int mg = m0 + mm;
                const int grow = u.pm * 256 + ai * 128 + mg * 16 + wr * 64 + fr;
                float s = 0.f, ss = 0.f;
#pragma unroll
                for (int bj = 0; bj < 2; ++bj) { const size_t off = (size_t)grow * 1024 + u.pn * 256 + bj * 128 + lc; const u32x4 ww = w[m][bj];
                    f32x4 x0 = (f32x4){lo_bf(ww.x), hi_bf(ww.x), lo_bf(ww.y), hi_bf(ww.y)}, x1 = (f32x4){lo_bf(ww.z), hi_bf(ww.z), lo_bf(ww.w), hi_bf(ww.w)};
                    x0 = (x0 - mu[m]) * rs[m] * gv[bj][0] + bv[bj][0]; x1 = (x1 - mu[m]) * rs[m] * gv[bj][1] + bv[bj][1];
                    const f32x4 y0 = x0 * ALPHA + acc[ai][bj][mg][0], y1 = x1 * ALPHA + acc[ai][bj][mg][1];
                    *(u32x4*)(XB + off) = pack8(y0, y1);
                    s += (y0[0] + y0[1]) + (y0[2] + y0[3]) + (y1[0] + y1[1]) + (y1[2] + y1[3]);
                    ss += (y0[0] * y0[0] + y0[1] * y0[1]) + (y0[2] * y0[2] + y0[3] * y0[3]) + (y1[0] * y1[0] + y1[1] * y1[1]) + (y1[2] * y1[2] + y1[3] * y1[3]);
                }
                s += __shfl_xor(s, 16); s += __shfl_xor(s, 32); ss += __shfl_xor(ss, 16); ss += __shfl_xor(ss, 32);
                if (fq == 0) { f32x2_t o2 = {s, ss}; *(f32x2_t*)(st2 + (size_t)grow * 32 + (u.pn * 4 + wc) * 2) = o2; }
            }
        }
    }
};

struct MapIn { __device__ static int src(int n) { return n < 1536 ? n : (n < 3072 ? n + 32 : (n < 3104 ? n - 3072 + 1536 : -1)); }
               __device__ static float scale(int n) { return (n < 256 || (n >= 1536 && n < 2048)) ? 0.125f : 1.0f; } };
struct MapId { __device__ static int src(int n) { return n; } __device__ static float scale(int) { return 1.0f; } };
struct MapF1 { __device__ static int src(int n) { const int t = n >> 8, r = n & 255; return r < 128 ? t * 128 + r : 2816 + t * 128 + (r - 128); } __device__ static float scale(int) { return 1.0f; } };

template <class Map>
__device__ __forceinline__ void wt_unit(LAS float* lf, const float* W, int ldw, int K, bf16_t* Wt, int kt, int nt, const float* g, const float* b, float* c1, float* c2) {
    const int tid = opaque_tid();
    {   const int nl = tid & 63, n = nt * 64 + nl, src = Map::src(n); const float sc = Map::scale(n);
#pragma unroll
        for (int i = 0; i < 8; ++i) { const int kl = (tid >> 6) + 8 * i; lf[kl * 65 + nl] = src >= 0 ? W[(size_t)(kt * 64 + kl) * ldw + src] * sc : 0.f; } }
    __syncthreads();
    {   const int nl = tid >> 3, ks = (tid & 7) * 8, n = nt * 64 + nl; float v[8]; float s1 = 0.f, s2 = 0.f;
#pragma unroll
        for (int j = 0; j < 8; ++j) { const float w = lf[(ks + j) * 65 + nl]; const int k = kt * 64 + ks + j; const float gv = g ? g[k] : 1.0f; const float bv = b ? b[k] : 0.f;
            const float r = bf2f(f2bf(w * gv)); v[j] = r; s1 += r; s2 += w * bv; }
        u32x4 pk; pk.x = cvt_pk_bf16(v[0], v[1]); pk.y = cvt_pk_bf16(v[2], v[3]); pk.z = cvt_pk_bf16(v[4], v[5]); pk.w = cvt_pk_bf16(v[6], v[7]);
        *(u32x4*)(Wt + (size_t)n * K + kt * 64 + ks) = pk;
        if (c1) { s1 += __shfl_xor(s1, 1); s1 += __shfl_xor(s1, 2); s1 += __shfl_xor(s1, 4); s2 += __shfl_xor(s2, 1); s2 += __shfl_xor(s2, 2); s2 += __shfl_xor(s2, 4);
            if ((tid & 7) == 0) { atomicAdd(c1 + n, s1); atomicAdd(c2 + n, s2); } } }
    __syncthreads();
}

__device__ __forceinline__ void prologue_weights(const Params& p, LAS unsigned char* lds) {
    LAS float* lf = (LAS float*)lds;
    unsigned char* ws = p.ws;
    float* cv = (float*)(ws + OFF_CV);
    float *c1in = cv, *c2in = cv + 2 * NPROJ, *c1f1 = cv + 4 * NPROJ, *c2f1 = cv + 4 * NPROJ + 2 * NF1;
    for (int u = blockIdx.x; u < 6400; u += gridDim.x) {
        if (u < 1664) { const int l = u / 832, r = u % 832, kt = r / 52, nt = r % 52;
            wt_unit<MapIn>(lf, p.w_in + (size_t)l * DM * 3104, 3104, DM, (bf16_t*)(ws + OFF_WIN) + (size_t)l * NPROJ * DM, kt, nt,
                           l ? p.ln2g : nullptr, l ? p.ln2b : nullptr, l ? c1in + NPROJ : nullptr, l ? c2in + NPROJ : nullptr); }
        else if (u < 2176) { const int v = u - 1664, l = v / 256, r = v % 256, kt = r / 16, nt = r % 16;
            wt_unit<MapId>(lf, p.w_out + (size_t)l * DM * DM, DM, DM, (bf16_t*)(ws + OFF_WOUT) + (size_t)l * DM * DM, kt, nt, nullptr, nullptr, nullptr, nullptr); }
        else if (u < 4992) { const int v = u - 2176, l = v / 1408, r = v % 1408, kt = r / 88, nt = r % 88;
            wt_unit<MapF1>(lf, p.wf1 + (size_t)l * DM * NF1, NF1, DM, (bf16_t*)(ws + OFF_WF1) + (size_t)l * NF1 * DM, kt, nt,
                           p.ln1g + l * DM, p.ln1b + l * DM, c1f1 + l * NF1, c2f1 + l * NF1); }
        else { const int v = u - 4992, l = v / 704, r = v % 704, kt = r / 16, nt = r % 16;
            wt_unit<MapId>(lf, p.wf2 + (size_t)l * KF2 * DM, DM, KF2, (bf16_t*)(ws + OFF_WF2) + (size_t)l * DM * KF2, kt, nt, nullptr, nullptr, nullptr, nullptr); }
    }
}

__device__ __forceinline__ void convert_x(const float* xp, const float* xs, size_t grow0, bf16_t* XB) {
    const size_t n8 = (size_t)TC * DM / 8;
    for (size_t i = (size_t)blockIdx.x * 512 + opaque_tid(); i < n8; i += (size_t)gridDim.x * 512) {
        const float* x = xrow_ptr(xp, xs, grow0 + (i >> 7)) + (i & 127) * 8;
        const f32x4 a = *(const f32x4*)x, b = *(const f32x4*)(x + 4);
        *(u32x4*)(XB + i * 8) = pack8(a, b);
    }
}
__device__ __forceinline__ void final_ln(float* out, const bf16_t* y, const float* st2, const float* g, const float* b) {
    const int tid = opaque_tid(), lane = tid & 63, wv = tid >> 6;
    for (int row = blockIdx.x * 8 + wv; row < TC; row += gridDim.x * 8) {
        const f32x2_t pr = *(const f32x2_t*)(st2 + (size_t)row * 32 + (lane & 15) * 2);
        float s = pr[0], q = pr[1];
#pragma unroll
        for (int d = 1; d < 16; d <<= 1) { s += __shfl_xor(s, d); q += __shfl_xor(q, d); }
        const float mu = s * (1.0f / 1024.0f), rs = rsqrtf(fmaxf(q * (1.0f / 1024.0f) - mu * mu, 0.f) + LN_EPS);
#pragma unroll
        for (int k = 0; k < 2; ++k) { const int c8 = (k * 64 + lane) * 8; const u32x4 w = *(const u32x4*)(y + (size_t)row * 1024 + c8);
            const f32x4 x0 = (f32x4){lo_bf(w.x), hi_bf(w.x), lo_bf(w.y), hi_bf(w.y)}, x1 = (f32x4){lo_bf(w.z), hi_bf(w.z), lo_bf(w.w), hi_bf(w.w)};
            float* po = out + (size_t)row * 1024 + c8;
            *(f32x4*)po = (x0 - mu) * rs * *(const f32x4*)(g + c8) + *(const f32x4*)(b + c8);
            *(f32x4*)(po + 4) = (x1 - mu) * rs * *(const f32x4*)(g + c8 + 4) + *(const f32x4*)(b + c8 + 4); }
    }
}
__device__ __forceinline__ void zero_f32(float* p, size_t n) {
    for (size_t i = (size_t)blockIdx.x * 512 + opaque_tid(); i < n; i += (size_t)gridDim.x * 512) p[i] = 0.f;
}

__device__ __forceinline__ float log_sigmoid_f(float z) { return fminf(z, 0.f) - log1pf(expf(-fabsf(z))); }

typedef __attribute__((ext_vector_type(2))) float f32x2;
__device__ __forceinline__ f32x4 mfma16(bf16x8 a, bf16x8 b, f32x4 c) { return __builtin_amdgcn_mfma_f32_16x16x32_bf16(a, b, c, 0, 0, 0); }
__device__ __forceinline__ bf16x8 scale8(bf16x8 raw, f32x4 e0, f32x4 e1) {
    const u32x4 r = __builtin_bit_cast(u32x4, raw); u32x4 o;
    o.x = cvt_pk_bf16(lo_bf(r.x) * e0[0], hi_bf(r.x) * e0[1]); o.y = cvt_pk_bf16(lo_bf(r.y) * e0[2], hi_bf(r.y) * e0[3]);
    o.z = cvt_pk_bf16(lo_bf(r.z) * e1[0], hi_bf(r.z) * e1[1]); o.w = cvt_pk_bf16(lo_bf(r.w) * e1[2], hi_bf(r.w) * e1[3]);
    return __builtin_bit_cast(bf16x8, o);
}
constexpr int HALF_LDS = 45056;
constexpr int ROWP = 68;
#define MEMBAR() asm volatile("" ::: "memory")

__device__ __forceinline__ float log_sigmoid_fast(float z) {
    const float e = __builtin_amdgcn_exp2f(-1.44269504088896f * fabsf(z));
    return fminf(z, 0.f) - 0.693147180559945f * __builtin_amdgcn_logf(1.0f + e);
}
__device__ __forceinline__ void gla_gates(const LAS float* lrs, const float* w2, const float* gbias, int h, int d, int w, float (&pf)[16], float (&sb)[16]) {
    float wf[16], wb[16];
#pragma unroll
    for (int r = 0; r < 16; ++r) { wf[r] = w2[r * 256 + h * 64 + d]; wb[r] = w2[(16 + r) * 256 + h * 64 + d]; }
    const float bf = gbias[h * 64 + d], bb = gbias[256 + h * 64 + d];
#pragma unroll
    for (int j = 0; j < 16; ++j) {
        const LAS float* lr = lrs + (w * 16 + j) * 32;
        f32x2_t z2 = {bf, bb};
#pragma unroll
        for (int r4 = 0; r4 < 4; ++r4) { const f32x4 a = *(const LAS f32x4*)(lr + 4 * r4), b = *(const LAS f32x4*)(lr + 16 + 4 * r4);
#pragma unroll
            for (int q = 0; q < 4; ++q) { const f32x2_t x2 = {a[q], b[q]}, w2v = {wf[4 * r4 + q], wb[4 * r4 + q]}; z2 = __builtin_elementwise_fma(x2, w2v, z2); } }
        pf[j] = log_sigmoid_fast(z2[0]) * (1.0f / 16.0f); sb[j] = log_sigmoid_fast(z2[1]) * (1.0f / 16.0f);
    }
#pragma unroll
    for (int j = 1; j < 16; ++j) pf[j] += pf[j - 1];
#pragma unroll
    for (int j = 14; j >= 0; --j) sb[j] += sb[j + 1];
}

__device__ __forceinline__ void gla_g1(LAS unsigned char* lds, const bf16_t* KAT, const bf16_t* VAT, const float* LR, const float* w2, const float* gbias, bf16_t* DS, float* DEC, float* BC) {
    const int tid = opaque_tid(), half = tid >> 8, t256 = tid & 255, d = tid & 63, lane = tid & 63, fr = lane & 15, g = lane >> 4;
    const int w = __builtin_amdgcn_readfirstlane((tid >> 6) & 3);
    LAS float* tot = (LAS float*)(lds + half * HALF_LDS);
    LAS float* ETf = tot + 512; LAS float* ETb = ETf + 64 * ROWP; LAS float* LRS = ETb + 64 * ROWP;
    for (int it = blockIdx.x; it < CHB * 4 * 32 / 2; it += gridDim.x) {
        const int uid = it * 2 + half, c = uid & 31, h = (uid >> 5) & 3, bl = uid >> 7;
        const size_t row0 = (size_t)bl * SEQ + c * 64;
        const bf16_t* kat = KAT + ((size_t)(bl * 4 + h) * 64) * SEQ + c * 64;
        const bf16_t* vat = VAT + ((size_t)(bl * 4 + h) * 128) * SEQ + c * 64;
        const f32x4 l0 = *(const f32x4*)(LR + row0 * 32 + t256 * 8), l1 = *(const f32x4*)(LR + row0 * 32 + t256 * 8 + 4);
        bf16x8 bfr[2][2], kraw[2][4];
#pragma unroll
        for (int t = 0; t < 2; ++t) {
#pragma unroll
            for (int e = 0; e < 2; ++e) bfr[t][e] = *(const bf16x8*)(vat + (size_t)(16 * (2 * w + e) + fr) * SEQ + 32 * t + 8 * g);
#pragma unroll
            for (int mb = 0; mb < 4; ++mb) kraw[t][mb] = *(const bf16x8*)(kat + (size_t)(16 * mb + fr) * SEQ + 32 * t + 8 * g);
        }
        MEMBAR();
        *(LAS f32x4*)(LRS + t256 * 8) = l0; *(LAS f32x4*)(LRS + t256 * 8 + 4) = l1;
        __syncthreads();
        float pf[16], sb[16];
        gla_gates(LRS, w2, gbias, h, d, w, pf, sb);
        tot[w * 64 + d] = pf[15]; tot[(4 + w) * 64 + d] = sb[0];
        __syncthreads();
        float offf = 0.f, offb = 0.f, totf = 0.f, totb = 0.f;
#pragma unroll
        for (int q = 0; q < 4; ++q) { const float a = tot[q * 64 + d], b = tot[(4 + q) * 64 + d]; totf += a; totb += b; if (q < w) offf += a; if (q > w) offb += b; }
#pragma unroll
        for (int j4 = 0; j4 < 4; ++j4) { f32x4 vf, vb;
#pragma unroll
            for (int jj = 0; jj < 4; ++jj) { vf[jj] = __expf(totf - (offf + pf[j4 * 4 + jj])); vb[jj] = __expf(totb - (offb + sb[j4 * 4 + jj])); }
            *(LAS f32x4*)(ETf + d * ROWP + w * 16 + j4 * 4) = vf; *(LAS f32x4*)(ETb + d * ROWP + w * 16 + j4 * 4) = vb; }
        if (w == 0) { DEC[((size_t)uid * 2 + 0) * 64 + d] = __expf(totf); DEC[((size_t)uid * 2 + 1) * 64 + d] = __expf(totb); }
        {   float* bc = BC + (size_t)uid * 8192 + (w * 16) * 64 + d;
#pragma unroll
            for (int j = 0; j < 16; ++j) { bc[j * 64] = (offf + pf[j]) * 1.44269504088896f; bc[4096 + j * 64] = (offb + sb[j]) * 1.44269504088896f; } }
        __syncthreads();
        f32x4 acc[2][4][2];
#pragma unroll
        for (int a = 0; a < 2; ++a)
#pragma unroll
            for (int b = 0; b < 4; ++b)
#pragma unroll
                for (int e = 0; e < 2; ++e) acc[a][b][e] = (f32x4){0.f, 0.f, 0.f, 0.f};
#pragma unroll
        for (int t = 0; t < 2; ++t) {
#pragma unroll
            for (int mb = 0; mb < 4; ++mb) {
                const LAS float* ef = ETf + (16 * mb + fr) * ROWP + 32 * t + 8 * g; const LAS float* eb = ETb + (16 * mb + fr) * ROWP + 32 * t + 8 * g;
                const bf16x8 af = scale8(kraw[t][mb], *(const LAS f32x4*)ef, *(const LAS f32x4*)(ef + 4)), ab = scale8(kraw[t][mb], *(const LAS f32x4*)eb, *(const LAS f32x4*)(eb + 4));
#pragma unroll
                for (int e = 0; e < 2; ++e) { acc[0][mb][e] = mfma16(af, bfr[t][e], acc[0][mb][e]); acc[1][mb][e] = mfma16(ab, bfr[t][e], acc[1][mb][e]); }
            }
        }
#pragma unroll
        for (int dir = 0; dir < 2; ++dir)
#pragma unroll
            for (int mb = 0; mb < 4; ++mb)
#pragma unroll
                for (int e = 0; e < 2; ++e) { const f32x4 a = acc[dir][mb][e]; u32x2 o; o.x = cvt_pk_bf16(a[0], a[1]); o.y = cvt_pk_bf16(a[2], a[3]);
                    *(u32x2*)(DS + (((size_t)uid * 2 + dir) * 128 + 16 * (2 * w + e) + fr) * 64 + 16 * mb + 4 * g) = o; }
        __syncthreads();
    }
}

__device__ __forceinline__ void gla_g2(LAS unsigned char* lds, bf16_t* DS, const float* DEC) {
    const int tid = opaque_tid();
    LAS float* dl = (LAS float*)lds;
    for (int it = blockIdx.x; it < CHB * 4 * 2 * 2; it += gridDim.x) {
        const int e = (it & 1) * 512 + tid, bhd = it >> 1, dir = bhd & 1, bh = bhd >> 1;
        {   const int i4 = tid * 4, cc = i4 >> 6, dk = i4 & 63;
            *(LAS f32x4*)(dl + i4) = *(const f32x4*)(DEC + ((size_t)(bh * 32 + cc) * 2 + dir) * 64 + dk); }
        u32x4 dsv[32];
#pragma unroll
        for (int k = 0; k < 32; ++k) { const int c = dir ? 31 - k : k; dsv[k] = *(const u32x4*)(DS + ((size_t)(bh * 32 + c) * 2 + dir) * 8192 + (size_t)e * 8); }
        MEMBAR();
        __syncthreads();
        float S[8];
#pragma unroll
        for (int q = 0; q < 8; ++q) S[q] = 0.f;
#pragma unroll
        for (int k = 0; k < 32; ++k) { const int c = dir ? 31 - k : k;
            const f32x4 d0 = *(const LAS f32x4*)(dl + c * 64 + (e & 7) * 8), d1 = *(const LAS f32x4*)(dl + c * 64 + (e & 7) * 8 + 4);
            u32x4 o; o.x = cvt_pk_bf16(S[0], S[1]); o.y = cvt_pk_bf16(S[2], S[3]); o.z = cvt_pk_bf16(S[4], S[5]); o.w = cvt_pk_bf16(S[6], S[7]);
            *(u32x4*)(DS + ((size_t)(bh * 32 + c) * 2 + dir) * 8192 + (size_t)e * 8) = o;
            S[0] = d0[0] * S[0] + lo_bf(dsv[k].x); S[1] = d0[1] * S[1] + hi_bf(dsv[k].x); S[2] = d0[2] * S[2] + lo_bf(dsv[k].y); S[3] = d0[3] * S[3] + hi_bf(dsv[k].y);
            S[4] = d1[0] * S[4] + lo_bf(dsv[k].z); S[5] = d1[1] * S[5] + hi_bf(dsv[k].z); S[6] = d1[2] * S[6] + lo_bf(dsv[k].w); S[7] = d1[3] * S[7] + hi_bf(dsv[k].w); }
        __syncthreads();
    }
}

constexpr int G3_KRAW = 0, G3_VT = 9216, G3_SF = 27648, G3_SB = 46080, G3_TBF = 64512, G3_TBB = 81920, G3_KIF = 99328, G3_KIB = 108544, G3_RED = 117760;
__device__ __forceinline__ void g3_dma_tile(LAS unsigned char* dst, const unsigned char* src, int row_bytes_src, int D, int ninstr, int wv, int lane) {
    for (int q = wv; q < ninstr; q += 8) { const int C = 64 * q + lane, row = C / (D + 1), pos = min(C - row * (D + 1), D - 1);
        __builtin_amdgcn_global_load_lds((const unsigned*)(src + (size_t)row * row_bytes_src + pos * 16), (LAS unsigned*)(dst + q * 1024), 16, 0, 0); }
}
__device__ __forceinline__ void g3_dma_unit(LAS unsigned char* lds, const bf16_t* P, const bf16_t* VAT, const bf16_t* DS, const float* BC, int uid, int wv, int lane) {
    const int c = uid & 31, h = (uid >> 5) & 3, bl = uid >> 7;
    const size_t row0 = (size_t)bl * SEQ + c * 64;
    g3_dma_tile(lds + G3_KRAW, (const unsigned char*)(P + row0 * 2048 + 256 + h * 64), 4096, 8, 9, wv, lane);
    g3_dma_tile(lds + G3_VT, (const unsigned char*)(VAT + ((size_t)(bl * 4 + h) * 128) * SEQ + c * 64), SEQ * 2, 8, 18, wv, lane);
    g3_dma_tile(lds + G3_SF, (const unsigned char*)(DS + ((size_t)uid * 2 + 0) * 8192), 128, 8, 18, wv, lane);
    g3_dma_tile(lds + G3_SB, (const unsigned char*)(DS + ((size_t)uid * 2 + 1) * 8192), 128, 8, 18, wv, lane);
    g3_dma_tile(lds + G3_TBF, (const unsigned char*)(BC + (size_t)uid * 8192), 256, 16, 17, wv, lane);
    g3_dma_tile(lds + G3_TBB, (const unsigned char*)(BC + (size_t)uid * 8192 + 4096), 256, 16, 17, wv, lane);
}
__device__ __forceinline__ void gla_g3(LAS unsigned char* lds, const bf16_t* P, const bf16_t* VAT, const bf16_t* DS, const float* BC, const float* gn, bf16_t* MIX) {
    const int tid = opaque_tid(), lane = tid & 63, fr = lane & 15, g = lane >> 4;
    const int wv = __builtin_amdgcn_readfirstlane(tid >> 6), rb = wv & 3, dvh = wv >> 2;
    const int iq = 16 * rb + fr;
    const int nun = CHB * 4 * 32;
    int uid = blockIdx.x;
    if (uid < nun) g3_dma_unit(lds, P, VAT, DS, BC, uid, wv, lane);
    for (; uid < nun; uid += gridDim.x) {
        const int c = uid & 31, h = (uid >> 5) & 3, bl = uid >> 7;
        const size_t row0 = (size_t)bl * SEQ + c * 64, qrow = row0 + iq;
        bf16x8 qraw[2]; f32x4 gvv[4]; u32x2 rvv[4];
#pragma unroll
        for (int s2 = 0; s2 < 2; ++s2) qraw[s2] = *(const bf16x8*)(P + qrow * 2048 + h * 64 + 32 * s2 + 8 * g);
#pragma unroll
        for (int mb = 0; mb < 4; ++mb) { const int cc = h * 128 + 16 * (4 * dvh + mb) + 4 * g; gvv[mb] = *(const f32x4*)(gn + cc); rvv[mb] = *(const u32x2*)(P + qrow * 2048 + 512 + cc); }
        asm volatile("s_waitcnt vmcnt(0)" ::: "memory");
        __syncthreads();
        {
            const int j = 8 * wv + (lane >> 3), ch = lane & 7;
            const bf16x8 kr = *(const LAS bf16x8*)(lds + G3_KRAW + (j * 9 + ch) * 16);
            const LAS float* tf = (const LAS float*)(lds + G3_TBF + j * 272 + ch * 32); const LAS float* tb = (const LAS float*)(lds + G3_TBB + j * 272 + ch * 32);
            f32x4 a0 = *(const LAS f32x4*)tf, a1 = *(const LAS f32x4*)(tf + 4), b0 = *(const LAS f32x4*)tb, b1 = *(const LAS f32x4*)(tb + 4);
#pragma unroll
            for (int q = 0; q < 4; ++q) { a0[q] = __builtin_amdgcn_exp2f(-a0[q]); a1[q] = __builtin_amdgcn_exp2f(-a1[q]); b0[q] = __builtin_amdgcn_exp2f(-b0[q]); b1[q] = __builtin_amdgcn_exp2f(-b1[q]); }
            *(LAS bf16x8*)(lds + G3_KIF + (j * 9 + ch) * 16) = scale8(kr, a0, a1); *(LAS bf16x8*)(lds + G3_KIB + (j * 9 + ch) * 16) = scale8(kr, b0, b1);
        }
        bf16x8 qdf[2], qdb[2];
#pragma unroll
        for (int s2 = 0; s2 < 2; ++s2) {
            const LAS float* tf = (const LAS float*)(lds + G3_TBF + iq * 272 + (32 * s2 + 8 * g) * 4); const LAS float* tb = (const LAS float*)(lds + G3_TBB + iq * 272 + (32 * s2 + 8 * g) * 4);
            f32x4 a0 = *(const LAS f32x4*)tf, a1 = *(const LAS f32x4*)(tf + 4), b0 = *(const LAS f32x4*)tb, b1 = *(const LAS f32x4*)(tb + 4);
#pragma unroll
            for (int q = 0; q < 4; ++q) { a0[q] = __builtin_amdgcn_exp2f(a0[q]); a1[q] = __builtin_amdgcn_exp2f(a1[q]); b0[q] = __builtin_amdgcn_exp2f(b0[q]); b1[q] = __builtin_amdgcn_exp2f(b1[q]); }
            qdf[s2] = scale8(qraw[s2], a0, a1); qdb[s2] = scale8(qraw[s2], b0, b1);
        }
        __syncthreads();
        bf16x8 pfrag[2];
#pragma unroll
        for (int t = 0; t < 2; ++t) {
            f32x4 sf[2], sv[2];
#pragma unroll
            for (int u = 0; u < 2; ++u) {
                const int j = 32 * t + 8 * (fr >> 2) + 4 * u + (fr & 3);
                sf[u] = (f32x4){0.f, 0.f, 0.f, 0.f}; sv[u] = (f32x4){0.f, 0.f, 0.f, 0.f};
#pragma unroll
                for (int s2 = 0; s2 < 2; ++s2) {
                    sf[u] = mfma16(*(const LAS bf16x8*)(lds + G3_KIF + (j * 9 + 4 * s2 + g) * 16), qdf[s2], sf[u]);
                    sv[u] = mfma16(*(const LAS bf16x8*)(lds + G3_KIB + (j * 9 + 4 * s2 + g) * 16), qdb[s2], sv[u]);
                }
            }
            f32x4 p0, p1;
#pragma unroll
            for (int ii = 0; ii < 4; ++ii) { const int j0 = 32 * t + 8 * g + ii, j1 = j0 + 4; p0[ii] = (j0 <= iq) ? sf[0][ii] : sv[0][ii]; p1[ii] = (j1 <= iq) ? sf[1][ii] : sv[1][ii]; }
            pfrag[t] = __builtin_bit_cast(bf16x8, pack8(p0, p1));
        }
        f32x4 o[4];
#pragma unroll
        for (int mb = 0; mb < 4; ++mb) o[mb] = (f32x4){0.f, 0.f, 0.f, 0.f};
#pragma unroll
        for (int t = 0; t < 2; ++t)
#pragma unroll
            for (int mb = 0; mb < 4; ++mb) o[mb] = mfma16(*(const LAS bf16x8*)(lds + G3_VT + ((16 * (4 * dvh + mb) + fr) * 9 + 4 * t + g) * 16), pfrag[t], o[mb]);
#pragma unroll
        for (int s2 = 0; s2 < 2; ++s2)
#pragma unroll
            for (int mb = 0; mb < 4; ++mb) {
                o[mb] = mfma16(*(const LAS bf16x8*)(lds + G3_SF + ((16 * (4 * dvh + mb) + fr) * 9 + 4 * s2 + g) * 16), qdf[s2], o[mb]);
                o[mb] = mfma16(*(const LAS bf16x8*)(lds + G3_SB + ((16 * (4 * dvh + mb) + fr) * 9 + 4 * s2 + g) * 16), qdb[s2], o[mb]);
            }
        float ss = 0.f;
#pragma unroll
        for (int mb = 0; mb < 4; ++mb) ss += (o[mb][0] * o[mb][0] + o[mb][1] * o[mb][1]) + (o[mb][2] * o[mb][2] + o[mb][3] * o[mb][3]);
        ss += __shfl_xor(ss, 16); ss += __shfl_xor(ss, 32);
        LAS float* red = (LAS float*)(lds + G3_RED);
        if (g == 0) red[iq * 2 + dvh] = ss;
        __syncthreads();
        if (uid + (int)gridDim.x < nun) g3_dma_unit(lds, P, VAT, DS, BC, uid + (int)gridDim.x, wv, lane);
        const float rstd = rsqrtf((red[iq * 2] + red[iq * 2 + 1]) * (1.0f / 128.0f) + LN_EPS);
#pragma unroll
        for (int mb = 0; mb < 4; ++mb) {
            const int cc = h * 128 + 16 * (4 * dvh + mb) + 4 * g;
            const f32x4 gv = gvv[mb]; const u32x2 rv = rvv[mb];
            const float r0 = silu_f(lo_bf(rv.x)), r1 = silu_f(hi_bf(rv.x)), r2 = silu_f(lo_bf(rv.y)), r3 = silu_f(hi_bf(rv.y));
            u32x2 ov; ov.x = cvt_pk_bf16(o[mb][0] * rstd * gv[0] * r0, o[mb][1] * rstd * gv[1] * r1); ov.y = cvt_pk_bf16(o[mb][2] * rstd * gv[2] * r2, o[mb][3] * rstd * gv[3] * r3);
            *(u32x2*)(MIX + qrow * 1024 + cc) = ov;
        }
    }
    asm volatile("s_waitcnt vmcnt(0)" ::: "memory");
    __syncthreads();
}

constexpr int NAT_K_BYTES = 9 * 64 * 128, NAT_VROW = 73, NAT_V_BYTES = 64 * NAT_VROW * 16, NAT_R_OFF = NAT_K_BYTES + NAT_V_BYTES;
constexpr int NAT_LDS_END = NAT_R_OFF + 8 * 15 * 31 * 4;
__device__ __forceinline__ void nat_dma_k(LAS unsigned char* lds, const bf16_t* P, int wv, int lane, size_t brow, int h, int RB) {
#pragma unroll
    for (int q9 = 0; q9 < 9; ++q9) { const int q = wv + 8 * q9, C = 64 * q + lane, key = C >> 3, slot = C & 7, src = slot ^ ((key ^ (key >> 3)) & 7);
        const int row = min(RB + (key >> 6), 31), tok = row * 64 + (key & 63);
        __builtin_amdgcn_global_load_lds((const unsigned*)(P + (brow + tok) * 2048 + 1536 + h * 64 + src * 8), (LAS unsigned*)(lds + q * 1024), 16, 0, 0); }
}
__device__ __forceinline__ void nat_dma_v(LAS unsigned char* lds, const bf16_t* VBT, int wv, int lane, int bh, int RB) {
    const int pmax = (32 - RB) * 8 - 1;
#pragma unroll
    for (int q10 = 0; q10 < 10; ++q10) { const int q = wv + 8 * q10;
        if (q < NAT_VROW) { const int C = 64 * q + lane, d = C / NAT_VROW, pos = min(C - d * NAT_VROW, min(71, pmax));
            __builtin_amdgcn_global_load_lds((const unsigned*)(VBT + ((size_t)bh * 64 + d) * SEQ + RB * 64 + pos * 8), (LAS unsigned*)(lds + NAT_K_BYTES + q * 1024), 16, 0, 0); } }
}
__device__ __forceinline__ void nat_mfma(LAS unsigned char* lds, const bf16_t* P, const bf16_t* VBT, const float* rpb, bf16_t* MIX) {
    const int tid = opaque_tid(), lane = tid & 63, fr = lane & 15, g = lane >> 4;
    const int wv = __builtin_amdgcn_readfirstlane(tid >> 6);
    LAS float* rl = (LAS float*)(lds + NAT_R_OFF);
    for (int i = tid; i < 8 * 15 * 31; i += 512) rl[i] = rpb[i];
    const int kcl = 8 * (fr >> 2) + (fr & 3);
    const bool xcd_map = (gridDim.x & 7) == 0;
    const int nits = CHB * 8 * 16, kend = xcd_map ? nits / 8 : nits, kstep = xcd_map ? (int)(gridDim.x >> 3) : (int)gridDim.x;
    int k = xcd_map ? (int)(blockIdx.x >> 3) : (int)blockIdx.x;
    if (k < kend) { const int bh = xcd_map ? (k >> 4) * 8 + (int)(blockIdx.x & 7) : (k >> 4), rp = k & 15;
        nat_dma_k(lds, P, wv, lane, (size_t)(bh >> 3) * SEQ, bh & 7, min(max(2 * rp - 4, 0), 24)); }
    for (; k < kend; k += kstep) {
        const int bh = xcd_map ? (k >> 4) * 8 + (int)(blockIdx.x & 7) : (k >> 4), rp = k & 15;
        const int jq = wv & 3, r = rp * 2 + (wv >> 2), h = bh & 7, bl = bh >> 3;
        const int RB = min(max(2 * rp - 4, 0), 24), rs = min(max(r - 4, 0), 24), kb0 = min(max(16 * jq - 8, 0), 32);
        const size_t brow = (size_t)bl * SEQ;
        const size_t qrow = brow + r * 64 + 16 * jq + fr;
        bf16x8 qf[2];
#pragma unroll
        for (int s2 = 0; s2 < 2; ++s2) qf[s2] = *(const bf16x8*)(P + qrow * 2048 + 1024 + h * 64 + 32 * s2 + 8 * g);
        asm volatile("s_waitcnt vmcnt(0)" ::: "memory");
        __syncthreads();
        nat_dma_v(lds, VBT, wv, lane, bh, RB);
        f32x4 sc[8][2];
#pragma unroll
        for (int t = 0; t < 8; ++t)
#pragma unroll
            for (int u = 0; u < 2; ++u) {
                const int kl = (rs - RB + t) * 64 + kb0 + kcl + 4 * u, sw = (kl ^ (kl >> 3)) & 7;
                f32x4 a = (f32x4){0.f, 0.f, 0.f, 0.f};
#pragma unroll
                for (int s2 = 0; s2 < 2; ++s2) a = mfma16(*(const LAS bf16x8*)(lds + kl * 128 + (((s2 * 4 + g) ^ sw) << 4)), qf[s2], a);
                sc[t][u] = a;
            }
        const int qc = 16 * jq + fr, cst = min(max(qc - 8, 0), 48);
        float mx = -3.0e38f;
#pragma unroll
        for (int u = 0; u < 2; ++u)
#pragma unroll
            for (int ii = 0; ii < 4; ++ii) {
                const int kc = kb0 + 8 * g + 4 * u + ii; const bool valid = (kc >= cst) && (kc < cst + 16);
                const int co = min(max(kc - qc + 15, 0), 30);
                const LAS float* rp_ = rl + (h * 15 + rs - r + 7) * 31 + co;
                float bias[8];
#pragma unroll
                for (int t = 0; t < 8; ++t) bias[t] = rp_[t * 31];
#pragma unroll
                for (int t = 0; t < 8; ++t) asm volatile("" : "+v"(bias[t]));
#pragma unroll
                for (int t = 0; t < 8; ++t) { const float v = valid ? sc[t][u][ii] + bias[t] : -1.0e30f; sc[t][u][ii] = v; mx = fmaxf(mx, v); }
            }
        mx = fmaxf(mx, __shfl_xor(mx, 16)); mx = fmaxf(mx, __shfl_xor(mx, 32));
        float sum = 0.f;
        bf16x8 pf[8];
#pragma unroll
        for (int t = 0; t < 8; ++t) {
            f32x4 p0, p1;
#pragma unroll
            for (int ii = 0; ii < 4; ++ii) { p0[ii] = __expf(sc[t][0][ii] - mx); p1[ii] = __expf(sc[t][1][ii] - mx); sum += p0[ii] + p1[ii]; }
            pf[t] = __builtin_bit_cast(bf16x8, pack8(p0, p1));
        }
        sum += __shfl_xor(sum, 16); sum += __shfl_xor(sum, 32);
        const float inv = 1.0f / sum;
        asm volatile("s_waitcnt vmcnt(0)" ::: "memory");
        __syncthreads();
        if (k + kstep < kend) { const int k2 = k + kstep, bh2 = xcd_map ? (k2 >> 4) * 8 + (int)(blockIdx.x & 7) : (k2 >> 4), rp2 = k2 & 15;
            nat_dma_k(lds, P, wv, lane, (size_t)(bh2 >> 3) * SEQ, bh2 & 7, min(max(2 * rp2 - 4, 0), 24)); }
        f32x4 o[4];
#pragma unroll
        for (int mb = 0; mb < 4; ++mb) o[mb] = (f32x4){0.f, 0.f, 0.f, 0.f};
        const int vpos = (rs - RB) * 8 + (kb0 >> 3) + g;
#pragma unroll
        for (int t = 0; t < 8; ++t)
#pragma unroll
            for (int mb = 0; mb < 4; ++mb) o[mb] = mfma16(*(const LAS bf16x8*)(lds + NAT_K_BYTES + (((16 * mb + fr) * NAT_VROW + vpos + 8 * t) << 4)), pf[t], o[mb]);
#pragma unroll
        for (int mb = 0; mb < 4; ++mb) { u32x2 ov; ov.x = cvt_pk_bf16(o[mb][0] * inv, o[mb][1] * inv); ov.y = cvt_pk_bf16(o[mb][2] * inv, o[mb][3] * inv);
            *(u32x2*)(MIX + qrow * 1024 + 512 + h * 64 + 16 * mb + 4 * g) = ov; }
    }
    asm volatile("s_waitcnt vmcnt(0)" ::: "memory");
    __syncthreads();
}

#define XB_TMO      128
#define XB_XCNT(j)  (256  + 64 * (j))
#define XB_XSUB(j)  (1280 + 64 * (j))
#define XB_XGEN(j)  (2304 + 64 * (j))
#define XB_TOP      3328
#define XB_TOPGEN   3392
#define XCD_BAR_WORDS 3456
#define XB_SPIN_CAP (1u << 18)
__device__ __forceinline__ unsigned xb_ld(unsigned* p)              { return __hip_atomic_load(p, __ATOMIC_RELAXED, __HIP_MEMORY_SCOPE_AGENT); }
__device__ __forceinline__ unsigned xb_add(unsigned* p, unsigned v) { return __hip_atomic_fetch_add(p, v, __ATOMIC_RELAXED, __HIP_MEMORY_SCOPE_AGENT); }
__device__ __forceinline__ unsigned xb_xcc_id() { return (unsigned)__builtin_amdgcn_s_getreg((3 << 11) | 20) & 0xFu; }
#define XB_SPIN(cond, bar) do { unsigned _sp = 0; while (cond) { __builtin_amdgcn_s_sleep(1); \
    if ((++_sp & 255u) == 0u) { if (xb_ld(&(bar)[XB_TMO])) break; if (_sp > XB_SPIN_CAP) { atomicAdd(&(bar)[XB_TMO], 1u); break; } } } } while (0)
struct XcdBarrier { unsigned* bar; unsigned x; volatile LAS unsigned* st; };
__device__ __forceinline__ XcdBarrier xcd_barrier_post(unsigned* bar, volatile LAS unsigned* st) {
    XcdBarrier b; b.bar = bar; b.x = xb_xcc_id(); b.st = st;
    if (threadIdx.x == 0) (void)xb_add(&bar[XB_XCNT(b.x)], 1u);
    return b;
}
__device__ __forceinline__ void xcd_barrier_complete(unsigned* bar, unsigned x, unsigned& nloc, unsigned& nx) {
    const unsigned G = gridDim.x * gridDim.y * gridDim.z;
    unsigned sum, cnt, mine, sp = 0u;
    for (;;) {
        sum = 0u; cnt = 0u; mine = 0u;
#pragma unroll
        for (unsigned j = 0; j < 16; ++j) { const unsigned c = xb_ld(&bar[XB_XCNT(j)]); sum += c; cnt += (c > 0u) ? 1u : 0u; mine = (j == x) ? c : mine; }
        if (sum == G) break;
        __builtin_amdgcn_s_sleep(1);
        if ((++sp & 255u) == 0u) { if (xb_ld(&bar[XB_TMO])) break; if (sp > XB_SPIN_CAP) { atomicAdd(&bar[XB_TMO], 1u); break; } }
    }
    nloc = mine > 0u ? mine : 1u; nx = cnt > 0u ? cnt : 1u;
}
__device__ __forceinline__ void xcd_barrier(const XcdBarrier& b) {
    asm volatile("s_waitcnt vmcnt(0)" ::: "memory");
    __syncthreads();
    if (threadIdx.x == 0) {
        unsigned* bar = b.bar;
        __builtin_amdgcn_s_waitcnt(0);
        unsigned nloc = b.st[0], nx = b.st[1];
        if (nloc == 0u) { xcd_barrier_complete(bar, b.x, nloc, nx); b.st[0] = nloc; b.st[1] = nx; }
        const unsigned old = xb_add(&bar[XB_XSUB(b.x)], 1u);
        const unsigned gen = old / nloc;
        if (old + 1u == (gen + 1u) * nloc) {
            __builtin_amdgcn_fence(__ATOMIC_RELEASE, "agent");
            asm volatile("s_waitcnt vmcnt(0)" ::: "memory");
            const unsigned og = xb_add(&bar[XB_TOP], 1u);
            const unsigned tg = og / nx;
            if (og + 1u == (tg + 1u) * nx) xb_add(&bar[XB_TOPGEN], 1u);
            else XB_SPIN(xb_ld(&bar[XB_TOPGEN]) == tg, bar);
            __builtin_amdgcn_fence(__ATOMIC_ACQUIRE, "agent");
            xb_add(&bar[XB_XGEN(b.x)], 1u);
            asm volatile("s_waitcnt vmcnt(0)" ::: "memory");
        } else {
            XB_SPIN(xb_ld(&bar[XB_XGEN(b.x)]) == gen, bar);
            __builtin_amdgcn_fence(__ATOMIC_ACQUIRE, "agent");
            asm volatile("s_waitcnt vmcnt(0)" ::: "memory");
        }
    }
    __syncthreads();
}

constexpr int LDS_BAR_OFF = 160 * 1024 - 64;
static_assert(NAT_LDS_END <= LDS_BAR_OFF, "NAT LDS tiles overlap the barrier words");
__global__ void __launch_bounds__(512) fwd_megakernel(Params p) {
    extern __shared__ __attribute__((aligned(16))) unsigned char lds_raw[];
    LAS unsigned char* lds = (LAS unsigned char*)lds_raw;
    cg::grid_group grid = cg::this_grid();
    unsigned char* ws = p.ws;
#define W_XB ((bf16_t*)(ws + OFF_XB))
#define W_PB ((bf16_t*)(ws + OFF_P))
#define W_KAT ((bf16_t*)(ws + OFF_KAT))
#define W_VAT ((bf16_t*)(ws + OFF_VAT))
#define W_VBT ((bf16_t*)(ws + OFF_VBT))
#define W_LR ((float*)(ws + OFF_LR))
#define W_MIX ((bf16_t*)(ws + OFF_MIX))
#define W_Y1 ((float*)(ws + OFF_Y1))
#define W_Y1B ((bf16_t*)(ws + OFF_Y1B))
#define W_HB ((bf16_t*)(ws + OFF_H))
#define W_ST1 ((float*)(ws + OFF_ST1))
#define W_ST2 ((float*)(ws + OFF_ST2))
#define CVB ((const float*)(ws + OFF_CV))
#define c1in (CVB)
#define c2in (CVB + 2 * NPROJ)
#define c1f1 (CVB + 4 * NPROJ)
#define c2f1 (CVB + 4 * NPROJ + 2 * NF1)
#define GSYNC() do { for (int _r = 0; _r < SYNC_REPS; ++_r) xcd_barrier(xbar); } while (0)
    {   volatile LAS unsigned* stw = (volatile LAS unsigned*)(lds + LDS_BAR_OFF);
        if (threadIdx.x < 4) stw[threadIdx.x] = 0u;
        __syncthreads(); }
    const XcdBarrier xbar = xcd_barrier_post((unsigned*)(ws + OFF_BAR), (volatile LAS unsigned*)(lds + LDS_BAR_OFF));
    pg8::StaticOrder S;

#ifndef NO_PRO
    prologue_weights(p, lds);
#endif
    for (int c = 0; c < NCHUNK; ++c) {
        float* OUT = p.out + (size_t)c * TC * DM;
        convert_x(p.xp, p.xs, (size_t)c * TC, W_XB);
        if (c > 0) final_ln(p.out + (size_t)(c - 1) * TC * DM, W_Y1B, W_ST2, p.ln2g + DM, p.ln2b + DM);
        if (c == 0) grid.sync(); else GSYNC();
        for (int l = 0; l < 2; ++l) {
#ifndef NO_G1
            {   EpiProj E; E.P = W_PB; E.KAT = W_KAT; E.VAT = W_VAT; E.VBT = W_VBT; E.LR = W_LR;
                E.st = l ? W_ST2 : nullptr; E.c1 = c1in + l * NPROJ; E.c2 = c2in + l * NPROJ;
                pg8::Gemm g; g.A = W_XB; g.Bt = (const bf16_t*)(ws + OFF_WIN) + (size_t)l * NPROJ * DM; g.M = TC; g.N = NPROJ; g.K = DM;
                S.init(TC, NPROJ, gridDim.x, blockIdx.x);
                for (int rr = 0; rr < GEMM_REPS; ++rr) pg8::gemm_phase(lds, g, S, E); }
#endif
            GSYNC();
#ifndef NO_MIX
            for (int rep = 0; rep < MIX_REPS; ++rep) {
            for (int rr = 0; rr < NAT_REPS; ++rr) nat_mfma(lds, W_PB, W_VBT, p.rpb + (size_t)l * 8 * 15 * 31, W_MIX);
            for (int rr = 0; rr < G1_REPS; ++rr) gla_g1(lds, W_KAT, W_VAT, W_LR, p.gw2 + (size_t)l * 2 * 16 * 256, p.gb + (size_t)l * 2 * 256, (bf16_t*)(ws + OFF_DS), (float*)(ws + OFF_DEC), (float*)(ws + OFF_BC));
            GSYNC();
            gla_g2(lds, (bf16_t*)(ws + OFF_DS), (const float*)(ws + OFF_DEC));
            GSYNC();
            for (int rr = 0; rr < G3_REPS; ++rr) gla_g3(lds, W_PB, W_VAT, (const bf16_t*)(ws + OFF_DS), (const float*)(ws + OFF_BC), p.gng + (size_t)l * 512, W_MIX);
            GSYNC();
            }
#endif
#ifndef NO_G2
            {   EpiOut E; E.xres = W_XB; E.xp = p.xp; E.xs = p.xs; E.grow0 = (size_t)c * TC; E.st2 = l ? W_ST2 : nullptr; E.g2 = p.ln2g; E.b2 = p.ln2b; E.Y1B = W_Y1B; E.st1 = W_ST1;
                pg8::Gemm g; g.A = W_MIX; g.Bt = (const bf16_t*)(ws + OFF_WOUT) + (size_t)l * DM * DM; g.M = TC; g.N = DM; g.K = DM;
                S.init(TC, DM, gridDim.x, blockIdx.x);
                pg8::gemm_phase(lds, g, S, E); }
            GSYNC();
#endif
#ifndef NO_G3
            {   EpiF1 E; E.st1 = W_ST1; E.c1 = c1f1 + l * NF1; E.c2 = c2f1 + l * NF1; E.H = W_HB;
                pg8::Gemm g; g.A = W_Y1B; g.Bt = (const bf16_t*)(ws + OFF_WF1) + (size_t)l * NF1 * DM; g.M = TC; g.N = NF1; g.K = DM;
                S.init(TC, NF1, gridDim.x, blockIdx.x);
                for (int rr = 0; rr < GEMM_REPS; ++rr) pg8::gemm_phase(lds, g, S, E); }
            GSYNC();
#endif
#ifndef NO_G4
            {   EpiF2 E; E.Y1B = W_Y1B; E.st1 = W_ST1; E.g1 = p.ln1g + l * DM; E.b1 = p.ln1b + l * DM; E.OUT = OUT; E.XB = l ? W_Y1B : W_XB; E.st2 = W_ST2;
                pg8::Gemm g; g.A = W_HB; g.Bt = (const bf16_t*)(ws + OFF_WF2) + (size_t)l * DM * KF2; g.M = TC; g.N = DM; g.K = KF2;
                S.init(TC, DM, gridDim.x, blockIdx.x);
                pg8::gemm_phase(lds, g, S, E); }
#endif
            GSYNC();
        }
    }
    final_ln(p.out + (size_t)(NCHUNK - 1) * TC * DM, W_Y1B, W_ST2, p.ln2g + DM, p.ln2b + DM);
}

extern "C" void kernel_launch(void* const* d_in, const int* in_sizes, int n_in, void* d_out, int out_size, void* d_ws, size_t ws_size, hipStream_t stream) {
    constexpr size_t kLds = 160 * 1024;
    static int grid_blocks = 0;
    if (!grid_blocks) {
        int dev = 0, cus = 0, per_cu = 0;
        (void)hipGetDevice(&dev);
        (void)hipDeviceGetAttribute(&cus, hipDeviceAttributeMultiprocessorCount, dev);
        (void)hipFuncSetAttribute((const void*)fwd_megakernel, hipFuncAttributeMaxDynamicSharedMemorySize, (int)kLds);
        (void)hipOccupancyMaxActiveBlocksPerMultiprocessor(&per_cu, (const void*)fwd_megakernel, 512, kLds);
        if (per_cu < 1) per_cu = 1;
        grid_blocks = cus;
        if (n_in != 14 || ws_size < WS_END) { fprintf(stderr, "kernel_launch: unexpected n_in %d or ws_size %zu < %zu\n", n_in, ws_size, (size_t)WS_END); grid_blocks = -1; }
    }
    if (grid_blocks < 0) return;
    (void)hipMemsetAsync((unsigned char*)d_ws + OFF_CV, 0, al256(CV_BYTES) + BAR_BYTES, stream);
    Params p{};
    p.xp = (const float*)d_in[0]; p.xs = (const float*)d_in[1]; p.w_in = (const float*)d_in[2]; p.gw2 = (const float*)d_in[3]; p.gb = (const float*)d_in[4];
    p.gng = (const float*)d_in[5]; p.rpb = (const float*)d_in[6]; p.w_out = (const float*)d_in[7]; p.ln1g = (const float*)d_in[8]; p.ln1b = (const float*)d_in[9];
    p.wf1 = (const float*)d_in[10]; p.wf2 = (const float*)d_in[11]; p.ln2g = (const float*)d_in[12]; p.ln2b = (const float*)d_in[13];
    p.out = (float*)d_out; p.ws = (unsigned char*)d_ws;
    void* args[] = {&p};
    hipError_t e = hipLaunchCooperativeKernel((void*)fwd_megakernel, dim3(grid_blocks), dim3(512), args, kLds, stream);
    if (e != hipSuccess) fprintf(stderr, "cooperative launch failed: %s (grid %d)\n", hipGetErrorString(e), grid_blocks);
}
```

```cpp
#include <hip/hip_runtime.h>
#include <hip/hip_cooperative_groups.h>
#include <cstdio>
#ifndef NAT_REPS
#define NAT_REPS 1
#endif
#ifndef G1_REPS
#define G1_REPS 1
#endif
#ifndef G3_REPS
#define G3_REPS 1
#endif
#ifndef GEMM_REPS
#define GEMM_REPS 1
#endif
#ifndef MIX_REPS
#define MIX_REPS 1
#endif
#ifndef SYNC_REPS
#define SYNC_REPS 1
#endif
#ifndef NAIVE_NAT
#define NAIVE_NAT 0
#endif
#ifndef NAIVE_GLA
#define NAIVE_GLA 0
#endif
namespace cg = cooperative_groups;

#define LAS __attribute__((address_space(3)))
typedef unsigned short bf16_t;
typedef short bf16x8 __attribute__((ext_vector_type(8)));
typedef float f32x4 __attribute__((ext_vector_type(4)));
typedef unsigned u32x4 __attribute__((ext_vector_type(4)));
typedef unsigned u32x2 __attribute__((ext_vector_type(2)));

constexpr int DM = 1024, SEQ = 2048, CHB = 24, TC = CHB * SEQ, NCHUNK = 2, NPROMPT_ROWS = 32 * SEQ;
constexpr int NPROJ = 3328, NF1 = 5632, KF2 = 2816;
constexpr float ALPHA = 1.41421356237309515f, LN_EPS = 1e-5f;

constexpr size_t al256(size_t x) { return (x + 255) & ~(size_t)255; }
constexpr size_t OFF_WIN = 0;
constexpr size_t OFF_WOUT = OFF_WIN + al256(2ull * NPROJ * DM * 2);
constexpr size_t OFF_WF1 = OFF_WOUT + al256(2ull * DM * DM * 2);
constexpr size_t OFF_WF2 = OFF_WF1 + al256(2ull * NF1 * DM * 2);
constexpr size_t OFF_CV = OFF_WF2 + al256(2ull * DM * KF2 * 2);
constexpr size_t CV_BYTES = (2ull * NPROJ * 2 + 2ull * NF1 * 2) * 4;
constexpr size_t OFF_BAR = OFF_CV + al256(CV_BYTES);
constexpr size_t BAR_BYTES = 3456 * 4;
constexpr size_t OFF_XB = OFF_BAR + al256(BAR_BYTES);
constexpr size_t OFF_P = OFF_XB + al256((size_t)TC * 1024 * 2);
constexpr size_t OFF_KAT = OFF_P + al256((size_t)TC * 2048 * 2);
constexpr size_t OFF_VAT = OFF_KAT + al256((size_t)TC * 256 * 2);
constexpr size_t OFF_VBT = OFF_VAT + al256((size_t)TC * 512 * 2);
constexpr size_t OFF_LR = OFF_VBT + al256((size_t)TC * 512 * 2);
constexpr size_t OFF_MIX = OFF_LR + al256((size_t)TC * 32 * 4);
constexpr size_t OFF_Y1 = OFF_MIX + al256((size_t)TC * 1024 * 2);
constexpr size_t OFF_Y1B = OFF_Y1 + al256((size_t)TC * 1024 * 4);
constexpr size_t OFF_ST1 = OFF_Y1B + al256((size_t)TC * 1024 * 2);
constexpr size_t OFF_ST2 = OFF_ST1 + al256((size_t)TC * 32 * 4);
constexpr size_t OFF_DEC = OFF_ST2 + al256((size_t)TC * 32 * 4);
constexpr size_t WS_END = OFF_DEC + al256((size_t)CHB * 4 * 32 * 2 * 64 * 4);
constexpr size_t OFF_H = OFF_P;
constexpr size_t OFF_BC = OFF_Y1;
constexpr size_t OFF_DS = OFF_Y1B;
static_assert((size_t)TC * KF2 * 2 <= OFF_LR - OFF_P, "H does not fit its alias");
static_assert((size_t)CHB * 4 * 32 * 2 * 8192 * 2 <= (size_t)TC * 1024 * 2, "DS does not fit its alias");

struct Params {
    const float *xp, *xs, *w_in, *gw2, *gb, *gng, *rpb, *w_out, *ln1g, *ln1b, *wf1, *wf2, *ln2g, *ln2b;
    float* out; unsigned char* ws;
};

typedef __bf16 bf16x2_t __attribute__((ext_vector_type(2)));
typedef float f32x2_t __attribute__((ext_vector_type(2)));
__device__ __forceinline__ unsigned cvt_pk_bf16(float lo, float hi) { const f32x2_t f = {lo, hi}; const bf16x2_t v = __builtin_convertvector(f, bf16x2_t); return __builtin_bit_cast(unsigned, v); }
__device__ __forceinline__ bf16_t f2bf(float x) { return (bf16_t)(cvt_pk_bf16(x, 0.f) & 0xffffu); }
__device__ __forceinline__ float bf2f(bf16_t h) { return __uint_as_float(((unsigned)h) << 16); }
__device__ __forceinline__ float lo_bf(unsigned x) { return __uint_as_float(x << 16); }
__device__ __forceinline__ float hi_bf(unsigned x) { return __uint_as_float(x & 0xffff0000u); }
__device__ __forceinline__ float silu_f(float x) { return x * __builtin_amdgcn_rcpf(1.0f + __expf(-x)); }
__device__ __forceinline__ void row_stats(const float* st, int row, int fq, float& mu, float& rs) {
    const f32x4 a = *(const f32x4*)(st + (size_t)row * 32 + fq * 8), b = *(const f32x4*)(st + (size_t)row * 32 + fq * 8 + 4);
    float s = (a[0] + a[2]) + (b[0] + b[2]), q = (a[1] + a[3]) + (b[1] + b[3]);
    s += __shfl_xor(s, 16); s += __shfl_xor(s, 32); q += __shfl_xor(q, 16); q += __shfl_xor(q, 32);
    mu = s * (1.0f / 1024.0f); const float var = fmaxf(q * (1.0f / 1024.0f) - mu * mu, 0.f); rs = rsqrtf(var + LN_EPS);
}

__device__ __forceinline__ int opaque_tid() { int t = threadIdx.x; asm volatile("" : "+v"(t)); return t; }
__device__ __forceinline__ const float* xrow_ptr(const float* xp, const float* xs, size_t grow) {
    return grow < (size_t)NPROMPT_ROWS ? xp + grow * DM : xs + (grow - NPROMPT_ROWS) * DM;
}
namespace pg8 {
constexpr int BM = 256, BK = 64, HALF = 128, HTB = HALF * BK * 2, STAGE_BYTES = 8 * HTB, NXCD = 8, WGM = 8;
__host__ __device__ __forceinline__ int lds_byte(int r, int c) { const int st = (r >> 4) * 2 + (c >> 5), rr = r & 15, cc = c & 31, ob = rr * 64 + cc * 2; return st * 1024 + (ob ^ (((ob >> 9) & 1) << 5)); }
__host__ __device__ __forceinline__ void stage_rc(int b, int& R, int& C) { const int st = b / 1024, sb = b % 1024, swz = sb ^ (((sb >> 9) & 1) << 5); R = (st >> 1) * 16 + swz / 64; C = (st & 1) * 32 + (swz % 64) / 2; }
__host__ __device__ __forceinline__ int perm32(int rho) { const int n = rho >> 4, i = rho & 15; return 8 * (i >> 2) + 4 * n + (i & 3); }
struct Unit { int pm, pn; };
struct Gemm { const bf16_t* A; const bf16_t* Bt; int M, N, K; };
struct StaticOrder {
    int nM, nN, nwg, G, c;
    __host__ __device__ void init(int M, int N, int G_, int c_) { nM = M / BM; nN = N / BM; nwg = nM * nN; G = G_; c = c_; }
    __host__ __device__ bool next(int i, Unit& u) const {
        const long L = (long)i * G + c; if (L >= nwg) return false;
        int wgid = (int)L; { const int q = nwg / NXCD, r = nwg % NXCD, xcd = wgid % NXCD, off = wgid / NXCD; wgid = (xcd < r ? xcd * (q + 1) : r * (q + 1) + (xcd - r) * q) + off; }
        const int nig = WGM * nN, gid = wgid / nig, fm = gid * WGM, gsz = (nM - fm) < WGM ? (nM - fm) : WGM;
        u.pm = fm + ((wgid % nig) % gsz); u.pn = (wgid % nig) / gsz; return true;
    }
};
template <class Epi>
__device__ __forceinline__ void gemm_phase(LAS unsigned char* lds, const Gemm g, const StaticOrder& S, const Epi& E) {
    const int tid = opaque_tid(), wid = __builtin_amdgcn_readfirstlane(tid >> 6), lane = tid & 63, wr = wid >> 2, wc = wid & 3, fr = lane & 15, fq = lane >> 4;
    const int K = g.K, nt = K / BK;
    unsigned voffA[2], voffB[2];
#pragma unroll
    for (int i = 0; i < 2; ++i) { int R, C; stage_rc(tid * 16 + i * 8192, R, C); const int Rb = Epi::PERM ? ((R & ~31) + perm32(R & 31)) : R;
        voffA[i] = (unsigned)(R * K + C) * 2u; voffB[i] = (unsigned)(Rb * K + C) * 2u; }
    const size_t kstep = (size_t)(BK * 2);
    const size_t hstep = (size_t)HALF * K * 2;
    const size_t tstep = 2 * hstep;
    const unsigned ldsw = (unsigned)wid * 1024u;
    const int aoff = lds_byte(wr * 64 + fr, fq * 8), boff = lds_byte(wc * 32 + fr, fq * 8);
#define PG8_SA(b, h) (((b) * 2 + (h)) * HTB)
#define PG8_SB(b, h) ((4 + (b) * 2 + (h)) * HTB)
#define PG8_STAGE(bufoff, gbase, voff) do { _Pragma("unroll") for (int _i = 0; _i < 2; ++_i) \
        __builtin_amdgcn_global_load_lds((const unsigned*)((const char*)(gbase) + (voff)[_i]), (LAS unsigned*)(lds + (bufoff) + ldsw + _i * 8192), 16, 0, 0); } while (0)
#define PG8_LDA(dst, b, h) do { _Pragma("unroll") for (int m = 0; m < 4; ++m) _Pragma("unroll") for (int k = 0; k < 2; ++k) dst[m][k] = *(const LAS bf16x8*)(lds + PG8_SA(b, h) + aoff + m * 2048 + k * 1024); } while (0)
#define PG8_LDB(dst, b, h) do { _Pragma("unroll") for (int n = 0; n < 2; ++n) _Pragma("unroll") for (int k = 0; k < 2; ++k) dst[n][k] = *(const LAS bf16x8*)(lds + PG8_SB(b, h) + boff + n * 2048 + k * 1024); } while (0)
#define PG8_MMA(ai, bj, At, Bt) do { __builtin_amdgcn_s_setprio(1); _Pragma("unroll") for (int m = 0; m < 4; ++m) _Pragma("unroll") for (int n = 0; n < 2; ++n) _Pragma("unroll") for (int k = 0; k < 2; ++k) \
        acc[ai][bj][m][n] = __builtin_amdgcn_mfma_f32_16x16x32_bf16(Bt[n][k], At[m][k], acc[ai][bj][m][n], 0, 0, 0); __builtin_amdgcn_s_setprio(0); } while (0)
#define PG8_WAIT_V(n) asm volatile("s_waitcnt vmcnt(" #n ")" ::: "memory")
#define PG8_WAIT_L(n) asm volatile("s_waitcnt lgkmcnt(" #n ")" ::: "memory")
#define PG8_BAR __builtin_amdgcn_s_barrier()
#define PG8_SCHED __builtin_amdgcn_sched_barrier(0)
    Unit cur, nxt; int ui = 0;
    if (!S.next(0, cur)) return;
    f32x4 acc[2][2][4][2];
#pragma unroll
    for (int a = 0; a < 2; ++a)
#pragma unroll
        for (int b = 0; b < 2; ++b)
#pragma unroll
            for (int m = 0; m < 4; ++m)
#pragma unroll
                for (int n = 0; n < 2; ++n) acc[a][b][m][n] = (f32x4){0.f, 0.f, 0.f, 0.f};
    bf16x8 At[4][2], B0[2][2], B1[2][2];
    const char* cA = (const char*)g.A + (size_t)cur.pm * tstep; const char* cB = (const char*)g.Bt + (size_t)cur.pn * tstep;
    PG8_STAGE(PG8_SB(0, 0), cB, voffB); PG8_STAGE(PG8_SA(0, 0), cA, voffA); PG8_STAGE(PG8_SB(0, 1), cB + hstep, voffB); PG8_STAGE(PG8_SA(0, 1), cA + hstep, voffA);
    if (wr == 1) PG8_BAR;
    PG8_WAIT_V(4); PG8_BAR;
    PG8_STAGE(PG8_SB(1, 0), cB + kstep, voffB); PG8_STAGE(PG8_SA(1, 0), cA + kstep, voffA); PG8_STAGE(PG8_SB(1, 1), cB + hstep + kstep, voffB);
    PG8_WAIT_V(6); PG8_BAR;
    for (;;) {
        const bool has_next = S.next(ui + 1, nxt);
        const char* nA = has_next ? (const char*)g.A + (size_t)nxt.pm * tstep : cA; const char* nB = has_next ? (const char*)g.Bt + (size_t)nxt.pn * tstep : cB;
        for (int t = 0; t < nt; t += 2) {
            const bool last = (t == nt - 2);
            const char* a1 = cA + (size_t)(t + 1) * kstep;
            const char* a2 = last ? nA : cA + (size_t)(t + 2) * kstep; const char* b2 = last ? nB : cB + (size_t)(t + 2) * kstep;
            const char* a3 = a2 + kstep; const char* b3 = b2 + kstep;
            PG8_LDB(B0, 0, 0); PG8_SCHED; PG8_LDA(At, 0, 0); PG8_STAGE(PG8_SA(1, 1), a1 + hstep, voffA);
            PG8_WAIT_L(8); PG8_BAR; PG8_WAIT_L(0); PG8_MMA(0, 0, At, B0); PG8_BAR; PG8_SCHED;
            PG8_LDB(B1, 0, 1); PG8_STAGE(PG8_SB(0, 0), b2, voffB);
            PG8_BAR; PG8_WAIT_L(0); PG8_MMA(0, 1, At, B1); PG8_BAR;
            PG8_LDA(At, 0, 1); PG8_STAGE(PG8_SA(0, 0), a2, voffA);
            PG8_BAR; PG8_WAIT_L(0); PG8_MMA(1, 0, At, B0); PG8_BAR; PG8_SCHED;
            PG8_STAGE(PG8_SB(0, 1), b2 + hstep, voffB);
            PG8_WAIT_V(6); PG8_BAR; PG8_MMA(1, 1, At, B1); PG8_BAR;
            PG8_LDB(B0, 1, 0); PG8_SCHED; PG8_LDA(At, 1, 0); PG8_STAGE(PG8_SA(0, 1), a2 + hstep, voffA);
            PG8_WAIT_L(8); PG8_BAR; PG8_WAIT_L(0); PG8_MMA(0, 0, At, B0); PG8_BAR; PG8_SCHED;
            PG8_LDB(B1, 1, 1); PG8_STAGE(PG8_SB(1, 0), b3, voffB);
            PG8_BAR; PG8_WAIT_L(0); PG8_MMA(0, 1, At, B1); PG8_BAR;
            PG8_LDA(At, 1, 1); PG8_STAGE(PG8_SA(1, 0), a3, voffA);
            PG8_BAR; PG8_WAIT_L(0); PG8_MMA(1, 0, At, B0); PG8_BAR; PG8_SCHED;
            PG8_STAGE(PG8_SB(1, 1), b3 + hstep, voffB);
            PG8_WAIT_V(6); PG8_BAR; PG8_MMA(1, 1, At, B1); PG8_BAR;
        }
        E(acc, cur, wr, wc, fr, fq);
        if (!has_next) break;
#pragma unroll
        for (int a = 0; a < 2; ++a)
#pragma unroll
            for (int b = 0; b < 2; ++b)
#pragma unroll
                for (int m = 0; m < 4; ++m)
#pragma unroll
                    for (int n = 0; n < 2; ++n) acc[a][b][m][n] = (f32x4){0.f, 0.f, 0.f, 0.f};
        cur = nxt; cA = nA; cB = nB; ++ui;
    }
    PG8_WAIT_V(0);
    if (wr == 0) PG8_BAR;
    PG8_BAR;
#undef PG8_SA
#undef PG8_SB
#undef PG8_STAGE
#undef PG8_LDA
#undef PG8_LDB
#undef PG8_MMA
#undef PG8_WAIT_V
#undef PG8_WAIT_L
#undef PG8_BAR
#undef PG8_SCHED
}
}
using pg8::Unit;

__device__ __forceinline__ u32x4 pack8(const f32x4 a, const f32x4 b) { u32x4 w; w.x = cvt_pk_bf16(a[0], a[1]); w.y = cvt_pk_bf16(a[2], a[3]); w.z = cvt_pk_bf16(b[0], b[1]); w.w = cvt_pk_bf16(b[2], b[3]); return w; }
__device__ __forceinline__ void store_T8(bf16_t* p, const f32x4 a, const f32x4 b, const int odd) {
    bf16_t* q = odd ? p + 4 * (size_t)SEQ - 1 : p;
#pragma unroll
    for (int j = 0; j < 4; ++j) {
        const float pa = __shfl_xor(a[j], 1), pb = __shfl_xor(b[j], 1);
        *(unsigned*)(q + (size_t)j * SEQ) = odd ? cvt_pk_bf16(pb, b[j]) : cvt_pk_bf16(a[j], pa);
    }
}

struct EpiProj {
    static constexpr bool PERM = true;
    bf16_t *P, *KAT, *VAT, *VBT; float* LR;
    const float *st, *c1, *c2;
    __device__ __forceinline__ void operator()(const f32x4 (&acc)[2][2][4][2], const Unit& u, int wr, int wc, int fr_, int fq_) const {
        int fr = fr_, fq = fq_; asm volatile("" : "+v"(fr), "+v"(fq));
        const int pn = u.pn, lc = wc * 32 + fq * 8, bl = u.pm >> 3, tok0 = (u.pm & 7) * 256;
        f32x4 c1v[2][2], c2v[2][2];
#pragma unroll
        for (int bj = 0; bj < 2; ++bj)
#pragma unroll
            for (int n = 0; n < 2; ++n) {
                if (st) { c1v[bj][n] = *(const f32x4*)(c1 + pn * 256 + bj * 128 + lc + 4 * n); c2v[bj][n] = *(const f32x4*)(c2 + pn * 256 + bj * 128 + lc + 4 * n); }
                else { c1v[bj][n] = (f32x4){0.f, 0.f, 0.f, 0.f}; c2v[bj][n] = (f32x4){0.f, 0.f, 0.f, 0.f}; } }
        const bool isT = (pn == 1) || (pn == 2) || (pn == 3) || (pn == 10) || (pn == 11);
        const bool isP = !(pn == 2 || pn == 3 || pn >= 10);
        const int pcol0 = (pn < 2 ? pn : pn - 2) * 256;
        bf16_t* tb[2];
#pragma unroll
        for (int bj = 0; bj < 2; ++bj) { const int col = bj * 128 + lc;
            if (pn == 1) tb[bj] = KAT + ((size_t)(bl * 4 + (col >> 6)) * 64 + (col & 63)) * SEQ;
            else if (pn < 4) { const int cv = (pn - 2) * 256 + col; tb[bj] = VAT + ((size_t)(bl * 4 + (cv >> 7)) * 128 + (cv & 127)) * SEQ; }
            else { const int cv = (pn - 10) * 256 + col; tb[bj] = VBT + ((size_t)(bl * 8 + (cv >> 6)) * 64 + (cv & 63)) * SEQ; } }
#pragma unroll
        for (int ai = 0; ai < 2; ++ai) {
            float mus[4], rss[4];
#pragma unroll
            for (int q = 0; q < 4; ++q) { mus[q] = 0.f; rss[q] = 1.f; if (st) row_stats(st, u.pm * 256 + ai * 128 + q * 16 + wr * 64 + fr, fq, mus[q], rss[q]); }
            asm volatile("" ::: "memory");
#pragma unroll
            for (int m = 0; m < 4; ++m) {
                const int rt = ai * 128 + m * 16 + wr * 64 + fr, grow = u.pm * 256 + rt, tok = tok0 + rt;
                const float mu = mus[m], rs = rss[m];
#pragma unroll
                for (int bj = 0; bj < 2; ++bj) {
                    const f32x4 v0 = (acc[ai][bj][m][0] - mu * c1v[bj][0]) * rs + c2v[bj][0];
                    const f32x4 v1 = (acc[ai][bj][m][1] - mu * c1v[bj][1]) * rs + c2v[bj][1];
                    const int col = bj * 128 + lc;
                    if (pn == 12) { if (col < 32) { *(f32x4*)(LR + (size_t)grow * 32 + col) = v0; *(f32x4*)(LR + (size_t)grow * 32 + col + 4) = v1; } }
                    else {
                        if (isP) *(u32x4*)(P + (size_t)grow * 2048 + pcol0 + col) = pack8(v0, v1);
                        if (isT) store_T8(tb[bj] + tok, v0, v1, fr & 1);
                    }
                }
            }
        }
    }
};

struct EpiOut {
    static constexpr bool PERM = true;
    const bf16_t* xres; const float *xp, *xs; size_t grow0; const float *st2, *g2, *b2;
    bf16_t* Y1B; float* st1;
    __device__ __forceinline__ void operator()(const f32x4 (&acc)[2][2][4][2], const Unit& u, int wr, int wc, int fr_, int fq_) const {
        int fr = fr_, fq = fq_; asm volatile("" : "+v"(fr), "+v"(fq));
        const int lc = wc * 32 + fq * 8;
        const float* xb = xrow_ptr(xp, xs, grow0 + (size_t)u.pm * 256) - (size_t)u.pm * 256 * 1024;
        f32x4 gv[2][2], bv[2][2];
#pragma unroll
        for (int bj = 0; bj < 2; ++bj)
#pragma unroll
            for (int n = 0; n < 2; ++n) { const int col = u.pn * 256 + bj * 128 + lc + 4 * n;
                if (st2) { gv[bj][n] = *(const f32x4*)(g2 + col); bv[bj][n] = *(const f32x4*)(b2 + col); } else { gv[bj][n] = (f32x4){1.f, 1.f, 1.f, 1.f}; bv[bj][n] = (f32x4){0.f, 0.f, 0.f, 0.f}; } }
#pragma unroll
        for (int am = 0; am < 4; ++am) { const int ai = am >> 1, m0 = (am & 1) * 2;
            f32x4 xr[2][2][2]; float mu[2], rs[2];
#pragma unroll
            for (int mm = 0; mm < 2; ++mm) { const int m = mm; const int mg = m0 + mm;
                const int grow = u.pm * 256 + ai * 128 + mg * 16 + wr * 64 + fr;
#pragma unroll
                for (int bj = 0; bj < 2; ++bj) { const size_t off = (size_t)grow * 1024 + u.pn * 256 + bj * 128 + lc;
                    if (st2) { const u32x4 w = *(const u32x4*)(xres + off);
                        xr[m][bj][0] = (f32x4){lo_bf(w.x), hi_bf(w.x), lo_bf(w.y), hi_bf(w.y)}; xr[m][bj][1] = (f32x4){lo_bf(w.z), hi_bf(w.z), lo_bf(w.w), hi_bf(w.w)}; }
                    else { xr[m][bj][0] = *(const f32x4*)(xb + off); xr[m][bj][1] = *(const f32x4*)(xb + off + 4); } }
                mu[m] = 0.f; rs[m] = 1.f; if (st2) row_stats(st2, grow, fq, mu[m], rs[m]);
            }
            asm volatile("" ::: "memory");
#pragma unroll
            for (int mm = 0; mm < 2; ++mm) { const int m = mm; const int mg = m0 + mm;
                const int grow = u.pm * 256 + ai * 128 + mg * 16 + wr * 64 + fr;
                float s = 0.f, ss = 0.f;
#pragma unroll
                for (int bj = 0; bj < 2; ++bj) { const size_t off = (size_t)grow * 1024 + u.pn * 256 + bj * 128 + lc;
                    const f32x4 x0 = (xr[m][bj][0] - mu[m]) * rs[m] * gv[bj][0] + bv[bj][0], x1 = (xr[m][bj][1] - mu[m]) * rs[m] * gv[bj][1] + bv[bj][1];
                    const f32x4 y0 = x0 * ALPHA + acc[ai][bj][mg][0], y1 = x1 * ALPHA + acc[ai][bj][mg][1];
                    *(u32x4*)(Y1B + off) = pack8(y0, y1);
                    s += (y0[0] + y0[1]) + (y0[2] + y0[3]) + (y1[0] + y1[1]) + (y1[2] + y1[3]);
                    ss += (y0[0] * y0[0] + y0[1] * y0[1]) + (y0[2] * y0[2] + y0[3] * y0[3]) + (y1[0] * y1[0] + y1[1] * y1[1]) + (y1[2] * y1[2] + y1[3] * y1[3]);
                }
                s += __shfl_xor(s, 16); s += __shfl_xor(s, 32); ss += __shfl_xor(ss, 16); ss += __shfl_xor(ss, 32);
                if (fq == 0) { f32x2_t o2 = {s, ss}; *(f32x2_t*)(st1 + (size_t)grow * 32 + (u.pn * 4 + wc) * 2) = o2; }
            }
        }
    }
};

struct EpiF1 {
    static constexpr bool PERM = true;
    const float *st1, *c1, *c2; bf16_t* H;
    __device__ __forceinline__ void operator()(const f32x4 (&acc)[2][2][4][2], const Unit& u, int wr, int wc, int fr_, int fq_) const {
        int fr = fr_, fq = fq_; asm volatile("" : "+v"(fr), "+v"(fq));
        const int lc = wc * 32 + fq * 8;
        f32x4 c1v[2][2], c2v[2][2];
#pragma unroll
        for (int bj = 0; bj < 2; ++bj)
#pragma unroll
            for (int n = 0; n < 2; ++n) { c1v[bj][n] = *(const f32x4*)(c1 + u.pn * 256 + bj * 128 + lc + 4 * n); c2v[bj][n] = *(const f32x4*)(c2 + u.pn * 256 + bj * 128 + lc + 4 * n); }
        float mus[8], rss[8];
#pragma unroll
        for (int q = 0; q < 8; ++q) row_stats(st1, u.pm * 256 + (q >> 2) * 128 + (q & 3) * 16 + wr * 64 + fr, fq, mus[q], rss[q]);
        asm volatile("" ::: "memory");
#pragma unroll
        for (int ai = 0; ai < 2; ++ai)
#pragma unroll
            for (int m = 0; m < 4; ++m) {
                const int grow = u.pm * 256 + ai * 128 + m * 16 + wr * 64 + fr;
                const float mu = mus[ai * 4 + m], rs = rss[ai * 4 + m];
                f32x4 h[2];
#pragma unroll
                for (int n = 0; n < 2; ++n) {
                    const f32x4 g = (acc[ai][0][m][n] - mu * c1v[0][n]) * rs + c2v[0][n];
                    const f32x4 up = (acc[ai][1][m][n] - mu * c1v[1][n]) * rs + c2v[1][n];
#pragma unroll
                    for (int j = 0; j < 4; ++j) h[n][j] = silu_f(g[j]) * up[j];
                }
                *(u32x4*)(H + (size_t)grow * KF2 + u.pn * 128 + lc) = pack8(h[0], h[1]);
            }
    }
};

struct EpiF2 {
    static constexpr bool PERM = true;
    const bf16_t* Y1B; const float *st1, *g1, *b1; float* OUT; bf16_t* XB; float* st2;
    __device__ __forceinline__ void operator()(const f32x4 (&acc)[2][2][4][2], const Unit& u, int wr, int wc, int fr_, int fq_) const {
        int fr = fr_, fq = fq_; asm volatile("" : "+v"(fr), "+v"(fq));
        const int lc = wc * 32 + fq * 8;
        f32x4 gv[2][2], bv[2][2];
#pragma unroll
        for (int bj = 0; bj < 2; ++bj)
#pragma unroll
            for (int n = 0; n < 2; ++n) { const int col = u.pn * 256 + bj * 128 + lc + 4 * n; gv[bj][n] = *(const f32x4*)(g1 + col); bv[bj][n] = *(const f32x4*)(b1 + col); }
#pragma unroll
        for (int am = 0; am < 4; ++am) { const int ai = am >> 1, m0 = (am & 1) * 2;
            u32x4 w[2][2]; float mu[2], rs[2];
#pragma unroll
            for (int mm = 0; mm < 2; ++mm) { const int m = mm; const int mg = m0 + mm;
                const int grow = u.pm * 256 + ai * 128 + mg * 16 + wr * 64 + fr;
#pragma unroll
                for (int bj = 0; bj < 2; ++bj) w[m][bj] = *(const u32x4*)(Y1B + (size_t)grow * 1024 + u.pn * 256 + bj * 128 + lc);
                row_stats(st1, grow, fq, mu[m], rs[m]);
            }
            asm volatile("" ::: "memory");
#pragma unroll
            for (int mm = 0; mm < 2; ++mm) { const int m = mm; const int mg = m0 + mm;
                const int grow = u.pm * 256 + ai * 128 + mg * 16 + wr * 64 + fr;
                float s = 0.f, ss = 0.f;
#pragma unroll
                for (int bj = 0; bj < 2; ++bj) { const size_t off = (size_t)grow * 1024 + u.pn * 256 + bj * 128 + lc; const u32x4 ww = w[m][bj];
                    f32x4 x0 = (f32x4){lo_bf(ww.x), hi_bf(ww.x), lo_bf(ww.y), hi_bf(ww.y)}, x1 = (f32x4){lo_bf(ww.z), hi_bf(ww.z), lo_bf(ww.w), hi_bf(ww.w)};
                    x0 = (x0 - mu[m]) * rs[m] * gv[bj][0] + bv[bj][0]; x1 = (x1 - mu[m]) * rs[m] * gv[bj][1] + bv[bj][1];
                    const f32x4 y0 = x0 * ALPHA + acc[ai][bj][mg][0], y1 = x1 * ALPHA + acc[ai][bj][mg][1];
                    *(u32x4*)(XB + off) = pack8(y0, y1);
                    s += (y0[0] + y0[1]) + (y0[2] + y0[3]) + (y1[0] + y1[1]) + (y1[2] + y1[3]);
                    ss += (y0[0] * y0[0] + y0[1] * y0[1]) + (y0[2] * y0[2] + y0[3] * y0[3]) + (y1[0] * y1[0] + y1[1] * y1[1]) + (y1[2] * y1[2] + y1[3] * y1[3]);
                }
                s += __shfl_xor(s, 16); s += __shfl_xor(s, 32); ss += __shfl_xor(ss, 16); ss += __shfl_xor(ss, 32);
                if (fq == 0) { f32x2_t o2 = {s, ss}; *(f32x2_t*)(st2 + (size_t)grow * 32 + (u.pn * 4 + wc) * 2) = o2; }
            }
        }
    }
};

struct MapIn { __device__ static int src(int n) { return n < 1536 ? n : (n < 3072 ? n + 32 : (n < 3104 ? n - 3072 + 1536 : -1)); }
               __device__ static float scale(int n) { return (n < 256 || (n >= 1536 && n < 2048)) ? 0.125f : 1.0f; } };
struct MapId { __device__ static int src(int n) { return n; } __device__ static float scale(int) { return 1.0f; } };
struct MapF1 { __device__ static int src(int n) { const int t = n >> 8, r = n & 255; return r < 128 ? t * 128 + r : 2816 + t * 128 + (r - 128); } __device__ static float scale(int) { return 1.0f; } };

template <class Map>
__device__ __forceinline__ void wt_unit(LAS float* lf, const float* W, int ldw, int K, bf16_t* Wt, int kt, int nt, const float* g, const float* b, float* c1, float* c2) {
    const int tid = opaque_tid();
    {   const int nl = tid & 63, n = nt * 64 + nl, src = Map::src(n); const float sc = Map::scale(n);
#pragma unroll
        for (int i = 0; i < 8; ++i) { const int kl = (tid >> 6) + 8 * i; lf[kl * 65 + nl] = src >= 0 ? W[(size_t)(kt * 64 + kl) * ldw + src] * sc : 0.f; } }
    __syncthreads();
    {   const int nl = tid >> 3, ks = (tid & 7) * 8, n = nt * 64 + nl; float v[8]; float s1 = 0.f, s2 = 0.f;
#pragma unroll
        for (int j = 0; j < 8; ++j) { const float w = lf[(ks + j) * 65 + nl]; const int k = kt * 64 + ks + j; const float gv = g ? g[k] : 1.0f; const float bv = b ? b[k] : 0.f;
            const float r = bf2f(f2bf(w * gv)); v[j] = r; s1 += r; s2 += w * bv; }
        u32x4 pk; pk.x = cvt_pk_bf16(v[0], v[1]); pk.y = cvt_pk_bf16(v[2], v[3]); pk.z = cvt_pk_bf16(v[4], v[5]); pk.w = cvt_pk_bf16(v[6], v[7]);
        *(u32x4*)(Wt + (size_t)n * K + kt * 64 + ks) = pk;
        if (c1) { s1 += __shfl_xor(s1, 1); s1 += __shfl_xor(s1, 2); s1 += __shfl_xor(s1, 4); s2 += __shfl_xor(s2, 1); s2 += __shfl_xor(s2, 2); s2 += __shfl_xor(s2, 4);
            if ((tid & 7) == 0) { atomicAdd(c1 + n, s1); atomicAdd(c2 + n, s2); } } }
    __syncthreads();
}

__device__ __forceinline__ void prologue_weights(const Params& p, LAS unsigned char* lds) {
    LAS float* lf = (LAS float*)lds;
    unsigned char* ws = p.ws;
    float* cv = (float*)(ws + OFF_CV);
    float *c1in = cv, *c2in = cv + 2 * NPROJ, *c1f1 = cv + 4 * NPROJ, *c2f1 = cv + 4 * NPROJ + 2 * NF1;
    for (int u = blockIdx.x; u < 6400; u += gridDim.x) {
        if (u < 1664) { const int l = u / 832, r = u % 832, kt = r / 52, nt = r % 52;
            wt_unit<MapIn>(lf, p.w_in + (size_t)l * DM * 3104, 3104, DM, (bf16_t*)(ws + OFF_WIN) + (size_t)l * NPROJ * DM, kt, nt,
                           l ? p.ln2g : nullptr, l ? p.ln2b : nullptr, l ? c1in + NPROJ : nullptr, l ? c2in + NPROJ : nullptr); }
        else if (u < 2176) { const int v = u - 1664, l = v / 256, r = v % 256, kt = r / 16, nt = r % 16;
            wt_unit<MapId>(lf, p.w_out + (size_t)l * DM * DM, DM, DM, (bf16_t*)(ws + OFF_WOUT) + (size_t)l * DM * DM, kt, nt, nullptr, nullptr, nullptr, nullptr); }
        else if (u < 4992) { const int v = u - 2176, l = v / 1408, r = v % 1408, kt = r / 88, nt = r % 88;
            wt_unit<MapF1>(lf, p.wf1 + (size_t)l * DM * NF1, NF1, DM, (bf16_t*)(ws + OFF_WF1) + (size_t)l * NF1 * DM, kt, nt,
                           p.ln1g + l * DM, p.ln1b + l * DM, c1f1 + l * NF1, c2f1 + l * NF1); }
        else { const int v = u - 4992, l = v / 704, r = v % 704, kt = r / 16, nt = r % 16;
            wt_unit<MapId>(lf, p.wf2 + (size_t)l * KF2 * DM, DM, KF2, (bf16_t*)(ws + OFF_WF2) + (size_t)l * DM * KF2, kt, nt, nullptr, nullptr, nullptr, nullptr); }
    }
}

__device__ __forceinline__ void convert_x(const float* xp, const float* xs, size_t grow0, bf16_t* XB) {
    const size_t n8 = (size_t)TC * DM / 8;
    for (size_t i = (size_t)blockIdx.x * 512 + opaque_tid(); i < n8; i += (size_t)gridDim.x * 512) {
        const float* x = xrow_ptr(xp, xs, grow0 + (i >> 7)) + (i & 127) * 8;
        const f32x4 a = *(const f32x4*)x, b = *(const f32x4*)(x + 4);
        *(u32x4*)(XB + i * 8) = pack8(a, b);
    }
}
__device__ __forceinline__ void final_ln(float* out, const bf16_t* y, const float* st2, const float* g, const float* b) {
    const int tid = opaque_tid(), lane = tid & 63, wv = tid >> 6;
    for (int row = blockIdx.x * 8 + wv; row < TC; row += gridDim.x * 8) {
        const f32x2_t pr = *(const f32x2_t*)(st2 + (size_t)row * 32 + (lane & 15) * 2);
        float s = pr[0], q = pr[1];
#pragma unroll
        for (int d = 1; d < 16; d <<= 1) { s += __shfl_xor(s, d); q += __shfl_xor(q, d); }
        const float mu = s * (1.0f / 1024.0f), rs = rsqrtf(fmaxf(q * (1.0f / 1024.0f) - mu * mu, 0.f) + LN_EPS);
#pragma unroll
        for (int k = 0; k < 2; ++k) { const int c8 = (k * 64 + lane) * 8; const u32x4 w = *(const u32x4*)(y + (size_t)row * 1024 + c8);
            const f32x4 x0 = (f32x4){lo_bf(w.x), hi_bf(w.x), lo_bf(w.y), hi_bf(w.y)}, x1 = (f32x4){lo_bf(w.z), hi_bf(w.z), lo_bf(w.w), hi_bf(w.w)};
            float* po = out + (size_t)row * 1024 + c8;
            *(f32x4*)po = (x0 - mu) * rs * *(const f32x4*)(g + c8) + *(const f32x4*)(b + c8);
            *(f32x4*)(po + 4) = (x1 - mu) * rs * *(const f32x4*)(g + c8 + 4) + *(const f32x4*)(b + c8 + 4); }
    }
}
__device__ __forceinline__ void zero_f32(float* p, size_t n) {
    for (size_t i = (size_t)blockIdx.x * 512 + opaque_tid(); i < n; i += (size_t)gridDim.x * 512) p[i] = 0.f;
}

__device__ __forceinline__ float log_sigmoid_f(float z) { return fminf(z, 0.f) - log1pf(expf(-fabsf(z))); }

typedef __attribute__((ext_vector_type(2))) float f32x2;
__device__ __forceinline__ f32x4 mfma16(bf16x8 a, bf16x8 b, f32x4 c) { return __builtin_amdgcn_mfma_f32_16x16x32_bf16(a, b, c, 0, 0, 0); }
__device__ __forceinline__ bf16x8 scale8(bf16x8 raw, f32x4 e0, f32x4 e1) {
    const u32x4 r = __builtin_bit_cast(u32x4, raw); u32x4 o;
    o.x = cvt_pk_bf16(lo_bf(r.x) * e0[0], hi_bf(r.x) * e0[1]); o.y = cvt_pk_bf16(lo_bf(r.y) * e0[2], hi_bf(r.y) * e0[3]);
    o.z = cvt_pk_bf16(lo_bf(r.z) * e1[0], hi_bf(r.z) * e1[1]); o.w = cvt_pk_bf16(lo_bf(r.w) * e1[2], hi_bf(r.w) * e1[3]);
    return __builtin_bit_cast(bf16x8, o);
}
constexpr int HALF_LDS = 45056;
constexpr int ROWP = 68;
#define MEMBAR() asm volatile("" ::: "memory")

__device__ __forceinline__ float log_sigmoid_fast(float z) {
    const float e = __builtin_amdgcn_exp2f(-1.44269504088896f * fabsf(z));
    return fminf(z, 0.f) - 0.693147180559945f * __builtin_amdgcn_logf(1.0f + e);
}
__device__ __forceinline__ void gla_gates(const LAS float* lrs, const float* w2, const float* gbias, int h, int d, int w, float (&pf)[16], float (&sb)[16]) {
    float wf[16], wb[16];
#pragma unroll
    for (int r = 0; r < 16; ++r) { wf[r] = w2[r * 256 + h * 64 + d]; wb[r] = w2[(16 + r) * 256 + h * 64 + d]; }
    const float bf = gbias[h * 64 + d], bb = gbias[256 + h * 64 + d];
#pragma unroll
    for (int j = 0; j < 16; ++j) {
        const LAS float* lr = lrs + (w * 16 + j) * 32;
        f32x2_t z2 = {bf, bb};
#pragma unroll
        for (int r4 = 0; r4 < 4; ++r4) { const f32x4 a = *(const LAS f32x4*)(lr + 4 * r4), b = *(const LAS f32x4*)(lr + 16 + 4 * r4);
#pragma unroll
            for (int q = 0; q < 4; ++q) { const f32x2_t x2 = {a[q], b[q]}, w2v = {wf[4 * r4 + q], wb[4 * r4 + q]}; z2 = __builtin_elementwise_fma(x2, w2v, z2); } }
        pf[j] = log_sigmoid_fast(z2[0]) * (1.0f / 16.0f); sb[j] = log_sigmoid_fast(z2[1]) * (1.0f / 16.0f);
    }
#pragma unroll
    for (int j = 1; j < 16; ++j) pf[j] += pf[j - 1];
#pragma unroll
    for (int j = 14; j >= 0; --j) sb[j] += sb[j + 1];
}

__device__ __forceinline__ void gla_g1(LAS unsigned char* lds, const bf16_t* KAT, const bf16_t* VAT, const float* LR, const float* w2, const float* gbias, bf16_t* DS, float* DEC, float* BC) {
    const int tid = opaque_tid(), half = tid >> 8, t256 = tid & 255, d = tid & 63, lane = tid & 63, fr = lane & 15, g = lane >> 4;
    const int w = __builtin_amdgcn_readfirstlane((tid >> 6) & 3);
    LAS float* tot = (LAS float*)(lds + half * HALF_LDS);
    LAS float* ETf = tot + 512; LAS float* ETb = ETf + 64 * ROWP; LAS float* LRS = ETb + 64 * ROWP;
    for (int it = blockIdx.x; it < CHB * 4 * 32 / 2; it += gridDim.x) {
        const int uid = it * 2 + half, c = uid & 31, h = (uid >> 5) & 3, bl = uid >> 7;
        const size_t row0 = (size_t)bl * SEQ + c * 64;
        const bf16_t* kat = KAT + ((size_t)(bl * 4 + h) * 64) * SEQ + c * 64;
        const bf16_t* vat = VAT + ((size_t)(bl * 4 + h) * 128) * SEQ + c * 64;
        const f32x4 l0 = *(const f32x4*)(LR + row0 * 32 + t256 * 8), l1 = *(const f32x4*)(LR + row0 * 32 + t256 * 8 + 4);
        bf16x8 bfr[2][2], kraw[2][4];
#pragma unroll
        for (int t = 0; t < 2; ++t) {
#pragma unroll
            for (int e = 0; e < 2; ++e) bfr[t][e] = *(const bf16x8*)(vat + (size_t)(16 * (2 * w + e) + fr) * SEQ + 32 * t + 8 * g);
#pragma unroll
            for (int mb = 0; mb < 4; ++mb) kraw[t][mb] = *(const bf16x8*)(kat + (size_t)(16 * mb + fr) * SEQ + 32 * t + 8 * g);
        }
        MEMBAR();
        *(LAS f32x4*)(LRS + t256 * 8) = l0; *(LAS f32x4*)(LRS + t256 * 8 + 4) = l1;
        __syncthreads();
        float pf[16], sb[16];
        gla_gates(LRS, w2, gbias, h, d, w, pf, sb);
        tot[w * 64 + d] = pf[15]; tot[(4 + w) * 64 + d] = sb[0];
        __syncthreads();
        float offf = 0.f, offb = 0.f, totf = 0.f, totb = 0.f;
#pragma unroll
        for (int q = 0; q < 4; ++q) { const float a = tot[q * 64 + d], b = tot[(4 + q) * 64 + d]; totf += a; totb += b; if (q < w) offf += a; if (q > w) offb += b; }
#pragma unroll
        for (int j4 = 0; j4 < 4; ++j4) { f32x4 vf, vb;
#pragma unroll
            for (int jj = 0; jj < 4; ++jj) { vf[jj] = __expf(totf - (offf + pf[j4 * 4 + jj])); vb[jj] = __expf(totb - (offb + sb[j4 * 4 + jj])); }
            *(LAS f32x4*)(ETf + d * ROWP + w * 16 + j4 * 4) = vf; *(LAS f32x4*)(ETb + d * ROWP + w * 16 + j4 * 4) = vb; }
        if (w == 0) { DEC[((size_t)uid * 2 + 0) * 64 + d] = __expf(totf); DEC[((size_t)uid * 2 + 1) * 64 + d] = __expf(totb); }
        {   float* bc = BC + (size_t)uid * 8192 + (w * 16) * 64 + d;
#pragma unroll
            for (int j = 0; j < 16; ++j) { bc[j * 64] = (offf + pf[j]) * 1.44269504088896f; bc[4096 + j * 64] = (offb + sb[j]) * 1.44269504088896f; } }
        __syncthreads();
        f32x4 acc[2][4][2];
#pragma unroll
        for (int a = 0; a < 2; ++a)
#pragma unroll
            for (int b = 0; b < 4; ++b)
#pragma unroll
                for (int e = 0; e < 2; ++e) acc[a][b][e] = (f32x4){0.f, 0.f, 0.f, 0.f};
#pragma unroll
        for (int t = 0; t < 2; ++t) {
#pragma unroll
            for (int mb = 0; mb < 4; ++mb) {
                const LAS float* ef = ETf + (16 * mb + fr) * ROWP + 32 * t + 8 * g; const LAS float* eb = ETb + (16 * mb + fr) * ROWP + 32 * t + 8 * g;
                const bf16x8 af = scale8(kraw[t][mb], *(const LAS f32x4*)ef, *(const LAS f32x4*)(ef + 4)), ab = scale8(kraw[t][mb], *(const LAS f32x4*)eb, *(const LAS f32x4*)(eb + 4));
#pragma unroll
                for (int e = 0; e < 2; ++e) { acc[0][mb][e] = mfma16(af, bfr[t][e], acc[0][mb][e]); acc[1][mb][e] = mfma16(ab, bfr[t][e], acc[1][mb][e]); }
            }
        }
#pragma unroll
        for (int dir = 0; dir < 2; ++dir)
#pragma unroll
            for (int mb = 0; mb < 4; ++mb)
#pragma unroll
                for (int e = 0; e < 2; ++e) { const f32x4 a = acc[dir][mb][e]; u32x2 o; o.x = cvt_pk_bf16(a[0], a[1]); o.y = cvt_pk_bf16(a[2], a[3]);
                    *(u32x2*)(DS + (((size_t)uid * 2 + dir) * 128 + 16 * (2 * w + e) + fr) * 64 + 16 * mb + 4 * g) = o; }
        __syncthreads();
    }
}

__device__ __forceinline__ void gla_g2(LAS unsigned char* lds, bf16_t* DS, const float* DEC) {
    const int tid = opaque_tid();
    LAS float* dl = (LAS float*)lds;
    for (int it = blockIdx.x; it < CHB * 4 * 2 * 2; it += gridDim.x) {
        const int e = (it & 1) * 512 + tid, bhd = it >> 1, dir = bhd & 1, bh = bhd >> 1;
        {   const int i4 = tid * 4, cc = i4 >> 6, dk = i4 & 63;
            *(LAS f32x4*)(dl + i4) = *(const f32x4*)(DEC + ((size_t)(bh * 32 + cc) * 2 + dir) * 64 + dk); }
        u32x4 dsv[32];
#pragma unroll
        for (int k = 0; k < 32; ++k) { const int c = dir ? 31 - k : k; dsv[k] = *(const u32x4*)(DS + ((size_t)(bh * 32 + c) * 2 + dir) * 8192 + (size_t)e * 8); }
        MEMBAR();
        __syncthreads();
        float S[8];
#pragma unroll
        for (int q = 0; q < 8; ++q) S[q] = 0.f;
#pragma unroll
        for (int k = 0; k < 32; ++k) { const int c = dir ? 31 - k : k;
            const f32x4 d0 = *(const LAS f32x4*)(dl + c * 64 + (e & 7) * 8), d1 = *(const LAS f32x4*)(dl + c * 64 + (e & 7) * 8 + 4);
            u32x4 o; o.x = cvt_pk_bf16(S[0], S[1]); o.y = cvt_pk_bf16(S[2], S[3]); o.z = cvt_pk_bf16(S[4], S[5]); o.w = cvt_pk_bf16(S[6], S[7]);
            *(u32x4*)(DS + ((size_t)(bh * 32 + c) * 2 + dir) * 8192 + (size_t)e * 8) = o;
            S[0] = d0[0] * S[0] + lo_bf(dsv[k].x); S[1] = d0[1] * S[1] + hi_bf(dsv[k].x); S[2] = d0[2] * S[2] + lo_bf(dsv[k].y); S[3] = d0[3] * S[3] + hi_bf(dsv[k].y);
            S[4] = d1[0] * S[4] + lo_bf(dsv[k].z); S[5] = d1[1] * S[5] + hi_bf(dsv[k].z); S[6] = d1[2] * S[6] + lo_bf(dsv[k].w); S[7] = d1[3] * S[7] + hi_bf(dsv[k].w); }
        __syncthreads();
    }
}

constexpr int G3_KRAW = 0, G3_VT = 9216, G3_SF = 27648, G3_SB = 46080, G3_TBF = 64512, G3_TBB = 81920, G3_KIF = 99328, G3_KIB = 108544, G3_RED = 117760;
__device__ __forceinline__ void g3_dma_tile(LAS unsigned char* dst, const unsigned char* src, int row_bytes_src, int D, int ninstr, int wv, int lane) {
    for (int q = wv; q < ninstr; q += 8) { const int C = 64 * q + lane, row = C / (D + 1), pos = min(C - row * (D + 1), D - 1);
        __builtin_amdgcn_global_load_lds((const unsigned*)(src + (size_t)row * row_bytes_src + pos * 16), (LAS unsigned*)(dst + q * 1024), 16, 0, 0); }
}
__device__ __forceinline__ void g3_dma_unit(LAS unsigned char* lds, const bf16_t* P, const bf16_t* VAT, const bf16_t* DS, const float* BC, int uid, int wv, int lane) {
    const int c = uid & 31, h = (uid >> 5) & 3, bl = uid >> 7;
    const size_t row0 = (size_t)bl * SEQ + c * 64;
    g3_dma_tile(lds + G3_KRAW, (const unsigned char*)(P + row0 * 2048 + 256 + h * 64), 4096, 8, 9, wv, lane);
    g3_dma_tile(lds + G3_VT, (const unsigned char*)(VAT + ((size_t)(bl * 4 + h) * 128) * SEQ + c * 64), SEQ * 2, 8, 18, wv, lane);
    g3_dma_tile(lds + G3_SF, (const unsigned char*)(DS + ((size_t)uid * 2 + 0) * 8192), 128, 8, 18, wv, lane);
    g3_dma_tile(lds + G3_SB, (const unsigned char*)(DS + ((size_t)uid * 2 + 1) * 8192), 128, 8, 18, wv, lane);
    g3_dma_tile(lds + G3_TBF, (const unsigned char*)(BC + (size_t)uid * 8192), 256, 16, 17, wv, lane);
    g3_dma_tile(lds + G3_TBB, (const unsigned char*)(BC + (size_t)uid * 8192 + 4096), 256, 16, 17, wv, lane);
}
__device__ __forceinline__ void gla_g3(LAS unsigned char* lds, const bf16_t* P, const bf16_t* VAT, const bf16_t* DS, const float* BC, const float* gn, bf16_t* MIX) {
    const int tid = opaque_tid(), lane = tid & 63, fr = lane & 15, g = lane >> 4;
    const int wv = __builtin_amdgcn_readfirstlane(tid >> 6), rb = wv & 3, dvh = wv >> 2;
    const int iq = 16 * rb + fr;
    const int nun = CHB * 4 * 32;
    int uid = blockIdx.x;
    if (uid < nun) g3_dma_unit(lds, P, VAT, DS, BC, uid, wv, lane);
    for (; uid < nun; uid += gridDim.x) {
        const int c = uid & 31, h = (uid >> 5) & 3, bl = uid >> 7;
        const size_t row0 = (size_t)bl * SEQ + c * 64, qrow = row0 + iq;
        bf16x8 qraw[2]; f32x4 gvv[4]; u32x2 rvv[4];
#pragma unroll
        for (int s2 = 0; s2 < 2; ++s2) qraw[s2] = *(const bf16x8*)(P + qrow * 2048 + h * 64 + 32 * s2 + 8 * g);
#pragma unroll
        for (int mb = 0; mb < 4; ++mb) { const int cc = h * 128 + 16 * (4 * dvh + mb) + 4 * g; gvv[mb] = *(const f32x4*)(gn + cc); rvv[mb] = *(const u32x2*)(P + qrow * 2048 + 512 + cc); }
        asm volatile("s_waitcnt vmcnt(0)" ::: "memory");
        __syncthreads();
        {
            const int j = 8 * wv + (lane >> 3), ch = lane & 7;
            const bf16x8 kr = *(const LAS bf16x8*)(lds + G3_KRAW + (j * 9 + ch) * 16);
            const LAS float* tf = (const LAS float*)(lds + G3_TBF + j * 272 + ch * 32); const LAS float* tb = (const LAS float*)(lds + G3_TBB + j * 272 + ch * 32);
            f32x4 a0 = *(const LAS f32x4*)tf, a1 = *(const LAS f32x4*)(tf + 4), b0 = *(const LAS f32x4*)tb, b1 = *(const LAS f32x4*)(tb + 4);
#pragma unroll
            for (int q = 0; q < 4; ++q) { a0[q] = __builtin_amdgcn_exp2f(-a0[q]); a1[q] = __builtin_amdgcn_exp2f(-a1[q]); b0[q] = __builtin_amdgcn_exp2f(-b0[q]); b1[q] = __builtin_amdgcn_exp2f(-b1[q]); }
            *(LAS bf16x8*)(lds + G3_KIF + (j * 9 + ch) * 16) = scale8(kr, a0, a1); *(LAS bf16x8*)(lds + G3_KIB + (j * 9 + ch) * 16) = scale8(kr, b0, b1);
        }
        bf16x8 qdf[2], qdb[2];
#pragma unroll
        for (int s2 = 0; s2 < 2; ++s2) {
            const LAS float* tf = (const LAS float*)(lds + G3_TBF + iq * 272 + (32 * s2 + 8 * g) * 4); const LAS float* tb = (const LAS float*)(lds + G3_TBB + iq * 272 + (32 * s2 + 8 * g) * 4);
            f32x4 a0 = *(const LAS f32x4*)tf, a1 = *(const LAS f32x4*)(tf + 4), b0 = *(const LAS f32x4*)tb, b1 = *(const LAS f32x4*)(tb + 4);
#pragma unroll
            for (int q = 0; q < 4; ++q) { a0[q] = __builtin_amdgcn_exp2f(a0[q]); a1[q] = __builtin_amdgcn_exp2f(a1[q]); b0[q] = __builtin_amdgcn_exp2f(b0[q]); b1[q] = __builtin_amdgcn_exp2f(b1[q]); }
            qdf[s2] = scale8(qraw[s2], a0, a1); qdb[s2] = scale8(qraw[s2], b0, b1);
        }
        __syncthreads();
        bf16x8 pfrag[2];
#pragma unroll
        for (int t = 0; t < 2; ++t) {
            f32x4 sf[2], sv[2];
#pragma unroll
            for (int u = 0; u < 2; ++u) {
                const int j = 32 * t + 8 * (fr >> 2) + 4 * u + (fr & 3);
                sf[u] = (f32x4){0.f, 0.f, 0.f, 0.f}; sv[u] = (f32x4){0.f, 0.f, 0.f, 0.f};
#pragma unroll
                for (int s2 = 0; s2 < 2; ++s2) {
                    sf[u] = mfma16(*(const LAS bf16x8*)(lds + G3_KIF + (j * 9 + 4 * s2 + g) * 16), qdf[s2], sf[u]);
                    sv[u] = mfma16(*(const LAS bf16x8*)(lds + G3_KIB + (j * 9 + 4 * s2 + g) * 16), qdb[s2], sv[u]);
                }
            }
            f32x4 p0, p1;
#pragma unroll
            for (int ii = 0; ii < 4; ++ii) { const int j0 = 32 * t + 8 * g + ii, j1 = j0 + 4; p0[ii] = (j0 <= iq) ? sf[0][ii] : sv[0][ii]; p1[ii] = (j1 <= iq) ? sf[1][ii] : sv[1][ii]; }
            pfrag[t] = __builtin_bit_cast(bf16x8, pack8(p0, p1));
        }
        f32x4 o[4];
#pragma unroll
        for (int mb = 0; mb < 4; ++mb) o[mb] = (f32x4){0.f, 0.f, 0.f, 0.f};
#pragma unroll
        for (int t = 0; t < 2; ++t)
#pragma unroll
            for (int mb = 0; mb < 4; ++mb) o[mb] = mfma16(*(const LAS bf16x8*)(lds + G3_VT + ((16 * (4 * dvh + mb) + fr) * 9 + 4 * t + g) * 16), pfrag[t], o[mb]);
#pragma unroll
        for (int s2 = 0; s2 < 2; ++s2)
#pragma unroll
            for (int mb = 0; mb < 4; ++mb) {
                o[mb] = mfma16(*(const LAS bf16x8*)(lds + G3_SF + ((16 * (4 * dvh + mb) + fr) * 9 + 4 * s2 + g) * 16), qdf[s2], o[mb]);
                o[mb] = mfma16(*(const LAS bf16x8*)(lds + G3_SB + ((16 * (4 * dvh + mb) + fr) * 9 + 4 * s2 + g) * 16), qdb[s2], o[mb]);
            }
        float ss = 0.f;
#pragma unroll
        for (int mb = 0; mb < 4; ++mb) ss += (o[mb][0] * o[mb][0] + o[mb][1] * o[mb][1]) + (o[mb][2] * o[mb][2] + o[mb][3] * o[mb][3]);
        ss += __shfl_xor(ss, 16); ss += __shfl_xor(ss, 32);
        LAS float* red = (LAS float*)(lds + G3_RED);
        if (g == 0) red[iq * 2 + dvh] = ss;
        __syncthreads();
        if (uid + (int)gridDim.x < nun) g3_dma_unit(lds, P, VAT, DS, BC, uid + (int)gridDim.x, wv, lane);
        const float rstd = rsqrtf((red[iq * 2] + red[iq * 2 + 1]) * (1.0f / 128.0f) + LN_EPS);
#pragma unroll
        for (int mb = 0; mb < 4; ++mb) {
            const int cc = h * 128 + 16 * (4 * dvh + mb) + 4 * g;
            const f32x4 gv = gvv[mb]; const u32x2 rv = rvv[mb];
            const float r0 = silu_f(lo_bf(rv.x)), r1 = silu_f(hi_bf(rv.x)), r2 = silu_f(lo_bf(rv.y)), r3 = silu_f(hi_bf(rv.y));
            u32x2 ov; ov.x = cvt_pk_bf16(o[mb][0] * rstd * gv[0] * r0, o[mb][1] * rstd * gv[1] * r1); ov.y = cvt_pk_bf16(o[mb][2] * rstd * gv[2] * r2, o[mb][3] * rstd * gv[3] * r3);
            *(u32x2*)(MIX + qrow * 1024 + cc) = ov;
        }
    }
    asm volatile("s_waitcnt vmcnt(0)" ::: "memory");
    __syncthreads();
}

constexpr int NAT_K_BYTES = 9 * 64 * 128, NAT_VROW = 73, NAT_V_BYTES = 64 * NAT_VROW * 16, NAT_R_OFF = NAT_K_BYTES + NAT_V_BYTES;
constexpr int NAT_LDS_END = NAT_R_OFF + 8 * 15 * 31 * 4;
__device__ __forceinline__ void nat_dma_k(LAS unsigned char* lds, const bf16_t* P, int wv, int lane, size_t brow, int h, int RB) {
#pragma unroll
    for (int q9 = 0; q9 < 9; ++q9) { const int q = wv + 8 * q9, C = 64 * q + lane, key = C >> 3, slot = C & 7, src = slot ^ ((key ^ (key >> 3)) & 7);
        const int row = min(RB + (key >> 6), 31), tok = row * 64 + (key & 63);
        __builtin_amdgcn_global_load_lds((const unsigned*)(P + (brow + tok) * 2048 + 1536 + h * 64 + src * 8), (LAS unsigned*)(lds + q * 1024), 16, 0, 0); }
}
__device__ __forceinline__ void nat_dma_v(LAS unsigned char* lds, const bf16_t* VBT, int wv, int lane, int bh, int RB) {
    const int pmax = (32 - RB) * 8 - 1;
#pragma unroll
    for (int q10 = 0; q10 < 10; ++q10) { const int q = wv + 8 * q10;
        if (q < NAT_VROW) { const int C = 64 * q + lane, d = C / NAT_VROW, pos = min(C - d * NAT_VROW, min(71, pmax));
            __builtin_amdgcn_global_load_lds((const unsigned*)(VBT + ((size_t)bh * 64 + d) * SEQ + RB * 64 + pos * 8), (LAS unsigned*)(lds + NAT_K_BYTES + q * 1024), 16, 0, 0); } }
}
__device__ __forceinline__ void nat_mfma(LAS unsigned char* lds, const bf16_t* P, const bf16_t* VBT, const float* rpb, bf16_t* MIX) {
    const int tid = opaque_tid(), lane = tid & 63, fr = lane & 15, g = lane >> 4;
    const int wv = __builtin_amdgcn_readfirstlane(tid >> 6);
    LAS float* rl = (LAS float*)(lds + NAT_R_OFF);
    for (int i = tid; i < 8 * 15 * 31; i += 512) rl[i] = rpb[i];
    const int kcl = 8 * (fr >> 2) + (fr & 3);
    const bool xcd_map = (gridDim.x & 7) == 0;
    const int nits = CHB * 8 * 16, kend = xcd_map ? nits / 8 : nits, kstep = xcd_map ? (int)(gridDim.x >> 3) : (int)gridDim.x;
    int k = xcd_map ? (int)(blockIdx.x >> 3) : (int)blockIdx.x;
    if (k < kend) { const int bh = xcd_map ? (k >> 4) * 8 + (int)(blockIdx.x & 7) : (k >> 4), rp = k & 15;
        nat_dma_k(lds, P, wv, lane, (size_t)(bh >> 3) * SEQ, bh & 7, min(max(2 * rp - 4, 0), 24)); }
    for (; k < kend; k += kstep) {
        const int bh = xcd_map ? (k >> 4) * 8 + (int)(blockIdx.x & 7) : (k >> 4), rp = k & 15;
        const int jq = wv & 3, r = rp * 2 + (wv >> 2), h = bh & 7, bl = bh >> 3;
        const int RB = min(max(2 * rp - 4, 0), 24), rs = min(max(r - 4, 0), 24), kb0 = min(max(16 * jq - 8, 0), 32);
        const size_t brow = (size_t)bl * SEQ;
        const size_t qrow = brow + r * 64 + 16 * jq + fr;
        bf16x8 qf[2];
#pragma unroll
        for (int s2 = 0; s2 < 2; ++s2) qf[s2] = *(const bf16x8*)(P + qrow * 2048 + 1024 + h * 64 + 32 * s2 + 8 * g);
        asm volatile("s_waitcnt vmcnt(0)" ::: "memory");
        __syncthreads();
        nat_dma_v(lds, VBT, wv, lane, bh, RB);
        f32x4 sc[8][2];
#pragma unroll
        for (int t = 0; t < 8; ++t)
#pragma unroll
            for (int u = 0; u < 2; ++u) {
                const int kl = (rs - RB + t) * 64 + kb0 + kcl + 4 * u, sw = (kl ^ (kl >> 3)) & 7;
                f32x4 a = (f32x4){0.f, 0.f, 0.f, 0.f};
#pragma unroll
                for (int s2 = 0; s2 < 2; ++s2) a = mfma16(*(const LAS bf16x8*)(lds + kl * 128 + (((s2 * 4 + g) ^ sw) << 4)), qf[s2], a);
                sc[t][u] = a;
            }
        const int qc = 16 * jq + fr, cst = min(max(qc - 8, 0), 48);
        float mx = -3.0e38f;
#pragma unroll
        for (int u = 0; u < 2; ++u)
#pragma unroll
            for (int ii = 0; ii < 4; ++ii) {
                const int kc = kb0 + 8 * g + 4 * u + ii; const bool valid = (kc >= cst) && (kc < cst + 16);
                const int co = min(max(kc - qc + 15, 0), 30);
                const LAS float* rp_ = rl + (h * 15 + rs - r + 7) * 31 + co;
                float bias[8];
#pragma unroll
                for (int t = 0; t < 8; ++t) bias[t] = rp_[t * 31];
#pragma unroll
                for (int t = 0; t < 8; ++t) asm volatile("" : "+v"(bias[t]));
#pragma unroll
                for (int t = 0; t < 8; ++t) { const float v = valid ? sc[t][u][ii] + bias[t] : -1.0e30f; sc[t][u][ii] = v; mx = fmaxf(mx, v); }
            }
        mx = fmaxf(mx, __shfl_xor(mx, 16)); mx = fmaxf(mx, __shfl_xor(mx, 32));
        float sum = 0.f;
        bf16x8 pf[8];
#pragma unroll
        for (int t = 0; t < 8; ++t) {
            f32x4 p0, p1;
#pragma unroll
            for (int ii = 0; ii < 4; ++ii) { p0[ii] = __expf(sc[t][0][ii] - mx); p1[ii] = __expf(sc[t][1][ii] - mx); sum += p0[ii] + p1[ii]; }
            pf[t] = __builtin_bit_cast(bf16x8, pack8(p0, p1));
        }
        sum += __shfl_xor(sum, 16); sum += __shfl_xor(sum, 32);
        const float inv = 1.0f / sum;
        asm volatile("s_waitcnt vmcnt(0)" ::: "memory");
        __syncthreads();
        if (k + kstep < kend) { const int k2 = k + kstep, bh2 = xcd_map ? (k2 >> 4) * 8 + (int)(blockIdx.x & 7) : (k2 >> 4), rp2 = k2 & 15;
            nat_dma_k(lds, P, wv, lane, (size_t)(bh2 >> 3) * SEQ, bh2 & 7, min(max(2 * rp2 - 4, 0), 24)); }
        f32x4 o[4];
#pragma unroll
        for (int mb = 0; mb < 4; ++mb) o[mb] = (f32x4){0.f, 0.f, 0.f, 0.f};
        const int vpos = (rs - RB) * 8 + (kb0 >> 3) + g;
#pragma unroll
        for (int t = 0; t < 8; ++t)
#pragma unroll
            for (int mb = 0; mb < 4; ++mb) o[mb] = mfma16(*(const LAS bf16x8*)(lds + NAT_K_BYTES + (((16 * mb + fr) * NAT_VROW + vpos + 8 * t) << 4)), pf[t], o[mb]);
#pragma unroll
        for (int mb = 0; mb < 4; ++mb) { u32x2 ov; ov.x = cvt_pk_bf16(o[mb][0] * inv, o[mb][1] * inv); ov.y = cvt_pk_bf16(o[mb][2] * inv, o[mb][3] * inv);
            *(u32x2*)(MIX + qrow * 1024 + 512 + h * 64 + 16 * mb + 4 * g) = ov; }
    }
    asm volatile("s_waitcnt vmcnt(0)" ::: "memory");
    __syncthreads();
}

#define XB_TMO      128
#define XB_XCNT(j)  (256  + 64 * (j))
#define XB_XSUB(j)  (1280 + 64 * (j))
#define XB_XGEN(j)  (2304 + 64 * (j))
#define XB_TOP      3328
#define XB_TOPGEN   3392
#define XCD_BAR_WORDS 3456
#define XB_SPIN_CAP (1u << 18)
__device__ __forceinline__ unsigned xb_ld(unsigned* p)              { return __hip_atomic_load(p, __ATOMIC_RELAXED, __HIP_MEMORY_SCOPE_AGENT); }
__device__ __forceinline__ unsigned xb_add(unsigned* p, unsigned v) { return __hip_atomic_fetch_add(p, v, __ATOMIC_RELAXED, __HIP_MEMORY_SCOPE_AGENT); }
__device__ __forceinline__ unsigned xb_xcc_id() { return (unsigned)__builtin_amdgcn_s_getreg((3 << 11) | 20) & 0xFu; }
#define XB_SPIN(cond, bar) do { unsigned _sp = 0; while (cond) { __builtin_amdgcn_s_sleep(1); \
    if ((++_sp & 255u) == 0u) { if (xb_ld(&(bar)[XB_TMO])) break; if (_sp > XB_SPIN_CAP) { atomicAdd(&(bar)[XB_TMO], 1u); break; } } } } while (0)
struct XcdBarrier { unsigned* bar; unsigned x; volatile LAS unsigned* st; };
__device__ __forceinline__ XcdBarrier xcd_barrier_post(unsigned* bar, volatile LAS unsigned* st) {
    XcdBarrier b; b.bar = bar; b.x = xb_xcc_id(); b.st = st;
    if (threadIdx.x == 0) (void)xb_add(&bar[XB_XCNT(b.x)], 1u);
    return b;
}
__device__ __forceinline__ void xcd_barrier_complete(unsigned* bar, unsigned x, unsigned& nloc, unsigned& nx) {
    const unsigned G = gridDim.x * gridDim.y * gridDim.z;
    unsigned sum, cnt, mine, sp = 0u;
    for (;;) {
        sum = 0u; cnt = 0u; mine = 0u;
#pragma unroll
        for (unsigned j = 0; j < 16; ++j) { const unsigned c = xb_ld(&bar[XB_XCNT(j)]); sum += c; cnt += (c > 0u) ? 1u : 0u; mine = (j == x) ? c : mine; }
        if (sum == G) break;
        __builtin_amdgcn_s_sleep(1);
        if ((++sp & 255u) == 0u) { if (xb_ld(&bar[XB_TMO])) break; if (sp > XB_SPIN_CAP) { atomicAdd(&bar[XB_TMO], 1u); break; } }
    }
    nloc = mine > 0u ? mine : 1u; nx = cnt > 0u ? cnt : 1u;
}
__device__ __forceinline__ void xcd_barrier(const XcdBarrier& b) {
    asm volatile("s_waitcnt vmcnt(0)" ::: "memory");
    __syncthreads();
    if (threadIdx.x == 0) {
        unsigned* bar = b.bar;
        __builtin_amdgcn_s_waitcnt(0);
        unsigned nloc = b.st[0], nx = b.st[1];
        if (nloc == 0u) { xcd_barrier_complete(bar, b.x, nloc, nx); b.st[0] = nloc; b.st[1] = nx; }
        const unsigned old = xb_add(&bar[XB_XSUB(b.x)], 1u);
        const unsigned gen = old / nloc;
        if (old + 1u == (gen + 1u) * nloc) {
            __builtin_amdgcn_fence(__ATOMIC_RELEASE, "agent");
            asm volatile("s_waitcnt vmcnt(0)" ::: "memory");
            const unsigned og = xb_add(&bar[XB_TOP], 1u);
            const unsigned tg = og / nx;
            if (og + 1u == (tg + 1u) * nx) xb_add(&bar[XB_TOPGEN], 1u);
            else XB_SPIN(xb_ld(&bar[XB_TOPGEN]) == tg, bar);
            __builtin_amdgcn_fence(__ATOMIC_ACQUIRE, "agent");
            xb_add(&bar[XB_XGEN(b.x)], 1u);
            asm volatile("s_waitcnt vmcnt(0)" ::: "memory");
        } else {
            XB_SPIN(xb_ld(&bar[XB_XGEN(b.x)]) == gen, bar);
            __builtin_amdgcn_fence(__ATOMIC_ACQUIRE, "agent");
            asm volatile("s_waitcnt vmcnt(0)" ::: "memory");
        }
    }
    __syncthreads();
}

constexpr int LDS_BAR_OFF = 160 * 1024 - 64;
static_assert(NAT_LDS_END <= LDS_BAR_OFF, "NAT LDS tiles overlap the barrier words");
__global__ void __launch_bounds__(512) fwd_megakernel(Params p) {
    extern __shared__ __attribute__((aligned(16))) unsigned char lds_raw[];
    LAS unsigned char* lds = (LAS unsigned char*)lds_raw;
    cg::grid_group grid = cg::this_grid();
    unsigned char* ws = p.ws;
#define W_XB ((bf16_t*)(ws + OFF_XB))
#define W_PB ((bf16_t*)(ws + OFF_P))
#define W_KAT ((bf16_t*)(ws + OFF_KAT))
#define W_VAT ((bf16_t*)(ws + OFF_VAT))
#define W_VBT ((bf16_t*)(ws + OFF_VBT))
#define W_LR ((float*)(ws + OFF_LR))
#define W_MIX ((bf16_t*)(ws + OFF_MIX))
#define W_Y1 ((float*)(ws + OFF_Y1))
#define W_Y1B ((bf16_t*)(ws + OFF_Y1B))
#define W_HB ((bf16_t*)(ws + OFF_H))
#define W_ST1 ((float*)(ws + OFF_ST1))
#define W_ST2 ((float*)(ws + OFF_ST2))
#define CVB ((const float*)(ws + OFF_CV))
#define c1in (CVB)
#define c2in (CVB + 2 * NPROJ)
#define c1f1 (CVB + 4 * NPROJ)
#define c2f1 (CVB + 4 * NPROJ + 2 * NF1)
#define GSYNC() do { for (int _r = 0; _r < SYNC_REPS; ++_r) xcd_barrier(xbar); } while (0)
    {   volatile LAS unsigned* stw = (volatile LAS unsigned*)(lds + LDS_BAR_OFF);
        if (threadIdx.x < 4) stw[threadIdx.x] = 0u;
        __syncthreads(); }
    const XcdBarrier xbar = xcd_barrier_post((unsigned*)(ws + OFF_BAR), (volatile LAS unsigned*)(lds + LDS_BAR_OFF));
    pg8::StaticOrder S;

#ifndef NO_PRO
    prologue_weights(p, lds);
#endif
    for (int c = 0; c < NCHUNK; ++c) {
        float* OUT = p.out + (size_t)c * TC * DM;
        convert_x(p.xp, p.xs, (size_t)c * TC, W_XB);
        if (c > 0) final_ln(p.out + (size_t)(c - 1) * TC * DM, W_Y1B, W_ST2, p.ln2g + DM, p.ln2b + DM);
        if (c == 0) grid.sync(); else GSYNC();
        for (int l = 0; l < 2; ++l) {
#ifndef NO_G1
            {   EpiProj E; E.P = W_PB; E.KAT = W_KAT; E.VAT = W_VAT; E.VBT = W_VBT; E.LR = W_LR;
                E.st = l ? W_ST2 : nullptr; E.c1 = c1in + l * NPROJ; E.c2 = c2in + l * NPROJ;
                pg8::Gemm g; g.A = W_XB; g.Bt = (const bf16_t*)(ws + OFF_WIN) + (size_t)l * NPROJ * DM; g.M = TC; g.N = NPROJ; g.K = DM;
                S.init(TC, NPROJ, gridDim.x, blockIdx.x);
                for (int rr = 0; rr < GEMM_REPS; ++rr) pg8::gemm_phase(lds, g, S, E); }
#endif
            GSYNC();
#ifndef NO_MIX
            for (int rep = 0; rep < MIX_REPS; ++rep) {
            for (int rr = 0; rr < NAT_REPS; ++rr) nat_mfma(lds, W_PB, W_VBT, p.rpb + (size_t)l * 8 * 15 * 31, W_MIX);
            for (int rr = 0; rr < G1_REPS; ++rr) gla_g1(lds, W_KAT, W_VAT, W_LR, p.gw2 + (size_t)l * 2 * 16 * 256, p.gb + (size_t)l * 2 * 256, (bf16_t*)(ws + OFF_DS), (float*)(ws + OFF_DEC), (float*)(ws + OFF_BC));
            GSYNC();
            gla_g2(lds, (bf16_t*)(ws + OFF_DS), (const float*)(ws + OFF_DEC));
            GSYNC();
            for (int rr = 0; rr < G3_REPS; ++rr) gla_g3(lds, W_PB, W_VAT, (const bf16_t*)(ws + OFF_DS), (const float*)(ws + OFF_BC), p.gng + (size_t)l * 512, W_MIX);
            GSYNC();
            }
#endif
#ifndef NO_G2
            {   EpiOut E; E.xres = W_XB; E.xp = p.xp; E.xs = p.xs; E.grow0 = (size_t)c * TC; E.st2 = l ? W_ST2 : nullptr; E.g2 = p.ln2g; E.b2 = p.ln2b; E.Y1B = W_Y1B; E.st1 = W_ST1;
                pg8::Gemm g; g.A = W_MIX; g.Bt = (const bf16_t*)(ws + OFF_WOUT) + (size_t)l * DM * DM; g.M = TC; g.N = DM; g.K = DM;
                S.init(TC, DM, gridDim.x, blockIdx.x);
                pg8::gemm_phase(lds, g, S, E); }
            GSYNC();
#endif
#ifndef NO_G3
            {   EpiF1 E; E.st1 = W_ST1; E.c1 = c1f1 + l * NF1; E.c2 = c2f1 + l * NF1; E.H = W_HB;
                pg8::Gemm g; g.A = W_Y1B; g.Bt = (const bf16_t*)(ws + OFF_WF1) + (size_t)l * NF1 * DM; g.M = TC; g.N = NF1; g.K = DM;
                S.init(TC, NF1, gridDim.x, blockIdx.x);
                for (int rr = 0; rr < GEMM_REPS; ++rr) pg8::gemm_phase(lds, g, S, E); }
            GSYNC();
#endif
#ifndef NO_G4
            {   EpiF2 E; E.Y1B = W_Y1B; E.st1 = W_ST1; E.g1 = p.ln1g + l * DM; E.b1 = p.ln1b + l * DM; E.OUT = OUT; E.XB = l ? W_Y1B : W_XB; E.st2 = W_ST2;
                pg8::Gemm g; g.A = W_HB; g.Bt = (const bf16_t*)(ws + OFF_WF2) + (size_t)l * DM * KF2; g.M = TC; g.N = DM; g.K = KF2;
                S.init(TC, DM, gridDim.x, blockIdx.x);
                pg8::gemm_phase(lds, g, S, E); }
#endif
            GSYNC();
        }
    }
    final_ln(p.out + (size_t)(NCHUNK - 1) * TC * DM, W_Y1B, W_ST2, p.ln2g + DM, p.ln2b + DM);
}

extern "C" void kernel_launch(void* const* d_in, const int* in_sizes, int n_in, void* d_out, int out_size, void* d_ws, size_t ws_size, hipStream_t stream) {
    constexpr size_t kLds = 160 * 1024;
    static int grid_blocks = 0;
    if (!grid_blocks) {
        int dev = 0, cus = 0, per_cu = 0;
        (void)hipGetDevice(&dev);
        (void)hipDeviceGetAttribute(&cus, hipDeviceAttributeMultiprocessorCount, dev);
        (void)hipFuncSetAttribute((const void*)fwd_megakernel, hipFuncAttributeMaxDynamicSharedMemorySize, (int)kLds);
        (void)hipOccupancyMaxActiveBlocksPerMultiprocessor(&per_cu, (const void*)fwd_megakernel, 512, kLds);
        if (per_cu < 1) per_cu = 1;
        grid_blocks = cus;
        if (n_in != 14 || ws_size < WS_END) { fprintf(stderr, "kernel_launch: unexpected n_in %d or ws_size %zu < %zu\n", n_in, ws_size, (size_t)WS_END); grid_blocks = -1; }
    }
    if (grid_blocks < 0) return;
    (void)hipMemsetAsync((unsigned char*)d_ws + OFF_CV, 0, al256(CV_BYTES) + BAR_BYTES, stream);
    Params p{};
    p.xp = (const float*)d_in[0]; p.xs = (const float*)d_in[1]; p.w_in = (const float*)d_in[2]; p.gw2 = (const float*)d_in[3]; p.gb = (const float*)d_in[4];
    p.gng = (const float*)d_in[5]; p.rpb = (const float*)d_in[6]; p.w_out = (const float*)d_in[7]; p.ln1g = (const float*)d_in[8]; p.ln1b = (const float*)d_in[9];
    p.wf1 = (const float*)d_in[10]; p.wf2 = (const float*)d_in[11]; p.ln2g = (const float*)d_in[12]; p.ln2b = (const float*)d_in[13];
    p.out = (float*)d_out; p.ws = (unsigned char*)d_ws;
    void* args[] = {&p};
    hipError_t e = hipLaunchCooperativeKernel((void*)fwd_megakernel, dim3(grid_blocks), dim3(512), args, kLds, stream);
    if (e != hipSuccess) fprintf(stderr, "cooperative launch failed: %s (grid %d)\n", hipGetErrorString(e), grid_blocks);
}
```
